# Optimizing an MI355X kernel written in HIP

```python
import math
import jax, jax.numpy as jnp
from jax import lax
import numpy as np

D_MODEL = 2048
BATCH = 16
SEQ = 256
DEPTH = 4
DEC_BATCH = 4
DEC_SEQ = 4096
PAST_LEN = 512

GRID_W = 64
F_GROUPS = 4
F_GROUP_DIM = 256
F_DIM = F_GROUPS * F_GROUP_DIM
N_HEADS = 8
QK_DIM = 64
V_DIM = 2 * QK_DIM
QK_W = N_HEADS * 2 * QK_DIM
V_W = N_HEADS * V_DIM
SPLIT_SIZES = (F_DIM, F_DIM, QK_W, QK_W, V_W, V_W, D_MODEL, D_MODEL)
IN_COLS = sum(SPLIT_SIZES)
Q_BLOCK = 128
ROPE_BASE = 10000.0
EPS = 1e-6

kernel_name = "hybrid_fourier_diffattn_dit_step"


def rms_norm(x, g):
    xf = x.astype(jnp.float32)
    y = xf * lax.rsqrt(jnp.mean(xf * xf, axis=-1, keepdims=True) + EPS)
    return (y * g.astype(jnp.float32)).astype(x.dtype)


def axial_rope_tables(n_tokens):
    rows = n_tokens // GRID_W
    r = jnp.repeat(jnp.arange(rows, dtype=jnp.float32), GRID_W)
    cidx = jnp.tile(jnp.arange(GRID_W, dtype=jnp.float32), rows)
    half = QK_DIM // 2
    inv = 1.0 / (ROPE_BASE ** (jnp.arange(half // 2, dtype=jnp.float32) * 2.0 / half))
    ang_r = r[:, None] * inv[None, :]
    ang_c = cidx[:, None] * inv[None, :]
    return (jnp.cos(ang_r), jnp.sin(ang_r), jnp.cos(ang_c), jnp.sin(ang_c))


def _rot_half(x, cos, sin):
    x1, x2 = jnp.split(x, 2, axis=-1)
    cos = cos[None, :, None, None, :]
    sin = sin[None, :, None, None, :]
    return jnp.concatenate([x1 * cos - x2 * sin, x2 * cos + x1 * sin], axis=-1)


def apply_axial_rope(x, rope):
    cos_r, sin_r, cos_c, sin_c = rope
    xf = x.astype(jnp.float32)
    xr, xc = jnp.split(xf, 2, axis=-1)
    out = jnp.concatenate([_rot_half(xr, cos_r, sin_r), _rot_half(xc, cos_c, sin_c)], axis=-1)
    return out.astype(x.dtype)


def diff_attention(q, k, v, lam, g_sub, lam_init):
    b, nq = q.shape[0], q.shape[1]
    nblk = nq // Q_BLOCK
    scale = QK_DIM ** -0.5
    kf = k.astype(jnp.float32)
    vf = v.astype(jnp.float32)
    qb = q.reshape(b, nblk, Q_BLOCK, N_HEADS, 2, QK_DIM).transpose(1, 0, 2, 3, 4, 5)

    def one_block(qblk):
        s = jnp.einsum('bqhce,bkhce->bhcqk', qblk.astype(jnp.float32), kf) * scale
        p = jax.nn.softmax(s, axis=-1)
        a = p[:, :, 0] - lam * p[:, :, 1]
        return jnp.einsum('bhqk,bkhd->bqhd', a, vf)

    o = lax.map(one_block, qb)
    o = o.transpose(1, 0, 2, 3, 4).reshape(b, nq, N_HEADS, V_DIM)
    o = o * lax.rsqrt(jnp.mean(o * o, axis=-1, keepdims=True) + EPS)
    o = o * g_sub.astype(jnp.float32) * (1.0 - lam_init)
    return o.astype(q.dtype)


def layer(x, cvec, params, lam_init, rope, k_ctx, v_ctx):
    (w_in, w_fproj, w_aproj, w_out, w_mod, b_mod, g_norm, g_q, g_k, g_sub,
     lq1, lk1, lq2, lk2) = params
    b, n = x.shape[0], x.shape[1]
    mod = jax.nn.silu(cvec) @ w_mod + b_mod
    shift, scale, gate = jnp.split(mod, 3, axis=-1)
    h = rms_norm(x, g_norm) * (1.0 + scale) + shift
    proj = h @ w_in
    idx = [int(i) for i in np.cumsum(SPLIT_SIZES)[:-1]]
    uf, zf, q, k, v, za, gf, ga = jnp.split(proj, idx, axis=-1)

    uf = uf.reshape(b, n, F_GROUPS, F_GROUP_DIM).astype(jnp.float32)
    yf = jnp.fft.fft2(uf, axes=(1, 3), norm='ortho').real.reshape(b, n, F_DIM).astype(x.dtype)
    yf = yf * jax.nn.silu(zf)

    q = rms_norm(q.reshape(b, n, N_HEADS, 2, QK_DIM), g_q)
    k = rms_norm(k.reshape(b, n, N_HEADS, 2, QK_DIM), g_k)
    v = v.reshape(b, n, N_HEADS, V_DIM)
    if rope is not None:
        q = apply_axial_rope(q, rope)
        k = apply_axial_rope(k, rope)
    if k_ctx is None:
        k_all, v_all = k, v
    else:
        k_all = jnp.concatenate([k_ctx.astype(k.dtype), k], axis=1)
        v_all = jnp.concatenate([v_ctx.astype(v.dtype), v], axis=1)
    lam = (jnp.exp(jnp.sum(lq1.astype(jnp.float32) * lk1.astype(jnp.float32)))
           - jnp.exp(jnp.sum(lq2.astype(jnp.float32) * lk2.astype(jnp.float32))) + lam_init)
    ya = diff_attention(q, k_all, v_all, lam, g_sub, lam_init).reshape(b, n, V_W)
    ya = ya * jax.nn.silu(za)

    merged = jax.nn.sigmoid(gf) * (yf @ w_fproj) + jax.nn.sigmoid(ga) * (ya @ w_aproj)
    out = merged @ w_out
    return x + gate * out, k, v


def setup_inputs(seed: int = 0) -> dict:
    key = jax.random.key(seed)
    ks = jax.random.split(key, 20)
    nrm = jax.random.normal
    d = D_MODEL
    return {
        "x_prompt": nrm(ks[0], (BATCH, SEQ, d), jnp.float32),
        "x_sample": nrm(ks[1], (DEC_BATCH, DEC_SEQ, d), jnp.float32),
        "c": nrm(ks[2], (DEC_BATCH, d), jnp.float32),
        "cache_k": nrm(ks[3], (DEC_BATCH, DEPTH, PAST_LEN, N_HEADS, 2, QK_DIM), jnp.float32),
        "cache_v": nrm(ks[4], (DEC_BATCH, DEPTH, PAST_LEN, N_HEADS, V_DIM), jnp.float32),
        "c_ctx": nrm(ks[5], (d,), jnp.float32),
        "w_in": nrm(ks[6], (DEPTH, d, IN_COLS), jnp.float32) * d ** -0.5,
        "w_fproj": nrm(ks[7], (DEPTH, F_DIM, d), jnp.float32) * F_DIM ** -0.5,
        "w_aproj": nrm(ks[8], (DEPTH, V_W, d), jnp.float32) * V_W ** -0.5,
        "w_out": nrm(ks[9], (DEPTH, d, d), jnp.float32) * d ** -0.5,
        "w_mod": nrm(ks[10], (DEPTH, d, 3 * d), jnp.float32) * d ** -0.5,
        "b_mod": nrm(ks[11], (DEPTH, 3 * d), jnp.float32) * 0.01,
        "g_norm": 1.0 + 0.05 * nrm(ks[12], (DEPTH, d), jnp.float32),
        "g_q": 1.0 + 0.05 * nrm(ks[13], (DEPTH, QK_DIM), jnp.float32),
        "g_k": 1.0 + 0.05 * nrm(ks[14], (DEPTH, QK_DIM), jnp.float32),
        "g_sub": 1.0 + 0.05 * nrm(ks[15], (DEPTH, V_DIM), jnp.float32),
        "lam_q1": 0.1 * nrm(ks[16], (DEPTH, QK_DIM), jnp.float32),
        "lam_k1": 0.1 * nrm(ks[17], (DEPTH, QK_DIM), jnp.float32),
        "lam_q2": 0.1 * nrm(ks[18], (DEPTH, QK_DIM), jnp.float32),
        "lam_k2": 0.1 * nrm(ks[19], (DEPTH, QK_DIM), jnp.float32),
    }


def reference(x_prompt, x_sample, c, cache_k, cache_v, c_ctx, w_in, w_fproj, w_aproj, w_out,
              w_mod, b_mod, g_norm, g_q, g_k, g_sub, lam_q1, lam_k1, lam_q2, lam_k2):
    rope = axial_rope_tables(x_sample.shape[1])
    cvec_ctx = c_ctx[None, None, :]
    cvec_lat = c[:, None, :]
    y_p = x_prompt
    y_s = x_sample
    ks_out = []
    vs_out = []
    for l in range(DEPTH):
        params = (w_in[l], w_fproj[l], w_aproj[l], w_out[l], w_mod[l], b_mod[l], g_norm[l],
                  g_q[l], g_k[l], g_sub[l], lam_q1[l], lam_k1[l], lam_q2[l], lam_k2[l])
        lam_init = 0.8 - 0.6 * math.exp(-0.3 * l)
        y_p, k_l, v_l = layer(y_p, cvec_ctx, params, lam_init, None, None, None)
        ks_out.append(k_l)
        vs_out.append(v_l)
        y_s, _, _ = layer(y_s, cvec_lat, params, lam_init, rope, cache_k[:, l], cache_v[:, l])
    new_cache_k = jnp.stack(ks_out, axis=1)
    new_cache_v = jnp.stack(vs_out, axis=1)
    return (y_p, y_s, new_cache_k, new_cache_v)
```

```cpp
#include <hip/hip_runtime.h>
#include <hip/hip_cooperative_groups.h>
#include <cstdio>
#include <cstdint>
namespace cg = cooperative_groups;

#define LAS __attribute__((address_space(3)))
typedef unsigned short bf16_t;
typedef short bf16x8 __attribute__((ext_vector_type(8)));
typedef float f32x2 __attribute__((ext_vector_type(2)));
typedef float f32x4 __attribute__((ext_vector_type(4)));
typedef float f32x16 __attribute__((ext_vector_type(16)));
typedef unsigned u32x2 __attribute__((ext_vector_type(2)));
typedef unsigned u32x4 __attribute__((ext_vector_type(4)));
typedef __bf16 bf16x2_t __attribute__((ext_vector_type(2)));

constexpr int D = 2048, DEPTH = 4, NTOK = 20480, NPROMPT = 4096, INC = 10240;
constexpr int PB = 16, PSEQ = 256, SB = 4, SSEQ = 4096, PAST = 512, SNK = PAST + SSEQ;
constexpr int C_UF = 0, C_ZF = 1024, C_Q = 2048, C_K = 3072, C_V = 4096, C_ZA = 5120, C_GF = 6144, C_GA = 8192;
constexpr float EPS = 1e-6f;
constexpr float LOG2E = 1.4426950408889634f;
constexpr float QSCALE = 0.125f * LOG2E;

constexpr size_t MiB = 1u << 20;
constexpr size_t WS_CTL = 0;
constexpr size_t WS_WIN = 1 * MiB;
constexpr size_t WS_WM = WS_WIN + 160 * MiB;
constexpr size_t WS_WO = WS_WM + 32 * MiB;
constexpr size_t WS_MODP = WS_WO + 32 * MiB;
constexpr size_t WS_MOD = WS_MODP + 8 * MiB;
constexpr size_t WS_TAB = WS_MOD + 1 * MiB;
constexpr size_t WS_T4096 = WS_TAB + 1 * MiB;
constexpr size_t WS_H = WS_T4096 + 64 * MiB;
constexpr size_t WS_P = WS_H + 80 * MiB;
constexpr size_t WS_ABT = WS_P + 400 * MiB;
constexpr size_t WS_Y = WS_ABT + 80 * MiB;
constexpr size_t WS_QN = WS_Y + 80 * MiB;
constexpr size_t WS_KC = WS_QN + 40 * MiB;
constexpr size_t WS_VT = WS_KC + 44 * MiB;
constexpr size_t WS_GN = WS_VT + 44 * MiB;
constexpr size_t WS_ZN = WS_GN + 160 * MiB;
constexpr size_t WS_END = WS_ZN + 40 * MiB;
__device__ __forceinline__ size_t nat_off(int tile, int ai, int m, int bj, int wave, int lane) { return ((((size_t)tile * 8 + ai * 4 + m) * 2 + bj) * 8 + wave) * 1024 + (size_t)lane * 16; }
constexpr int LDS_BYTES = 147456;

__device__ __forceinline__ float bf2f(unsigned b) { return __uint_as_float(b << 16); }
__device__ __forceinline__ unsigned cvtpk(float lo, float hi) { f32x2 v = {lo, hi}; bf16x2_t b = __builtin_convertvector(v, bf16x2_t); return __builtin_bit_cast(unsigned, b); }
__device__ __forceinline__ float sigmoidf_(float x) { return __builtin_amdgcn_rcpf(1.0f + __builtin_amdgcn_exp2f(-x * LOG2E)); }
__device__ __forceinline__ float siluf_(float x) { return x * sigmoidf_(x); }
__device__ __forceinline__ float wave_sum(float v) {
#pragma unroll
    for (int o = 1; o < 64; o <<= 1) v += __shfl_xor(v, o);
    return v;
}
__device__ __forceinline__ void unpack8(const u32x4 w, float* f) {
    f[0] = bf2f(w.x & 0xffffu); f[1] = bf2f(w.x >> 16); f[2] = bf2f(w.y & 0xffffu); f[3] = bf2f(w.y >> 16);
    f[4] = bf2f(w.z & 0xffffu); f[5] = bf2f(w.z >> 16); f[6] = bf2f(w.w & 0xffffu); f[7] = bf2f(w.w >> 16);
}

namespace pg8 {
constexpr int BM = 256, BK = 64, HALF = 128, HTB = HALF * BK * 2, STAGE_BYTES = 8 * HTB, NXCD = 8, WGM = 8;
__host__ __device__ __forceinline__ int lds_byte(int r, int c) { const int st = (r >> 4) * 2 + (c >> 5), rr = r & 15, cc = c & 31, ob = rr * 64 + cc * 2; return st * 1024 + (ob ^ (((ob >> 9) & 1) << 5)); }
__host__ __device__ __forceinline__ void stage_rc(int b, int& R, int& C) { const int st = b / 1024, sb = b % 1024, swz = sb ^ (((sb >> 9) & 1) << 5); R = (st >> 1) * 16 + swz / 64; C = (st & 1) * 32 + (swz % 64) / 2; }
__host__ __device__ __forceinline__ int perm32(int rho) { const int n = rho >> 4, i = rho & 15; return 8 * (i >> 2) + 4 * n + (i & 3); }

struct Unit { const char* aP; const char* bP; size_t co; int ldc; int r0, c0; };
struct Gemm { int lda, ldb, K; };

template <class Map> struct Order {
    int n, G, c; Map map;
    __device__ __forceinline__ bool next(int i, Unit& u) const { const long L = (long)i * G + c; if (L >= n) return false; map((int)L, u); return true; }
};
struct MapGrid {
    const char* A; const char* B; int nM, nN; size_t ars, brs; int pm0, pn0;
    __device__ __forceinline__ void operator()(int L, Unit& u) const {
        const int nwg = nM * nN; int wgid = L;
        { const int q = nwg / NXCD, r = nwg % NXCD, xcd = wgid % NXCD, off = wgid / NXCD; wgid = (xcd < r ? xcd * (q + 1) : r * (q + 1) + (xcd - r) * q) + off; }
        const int nig = WGM * nN, gid = wgid / nig, fm = gid * WGM, gsz = (nM - fm) < WGM ? (nM - fm) : WGM;
        const int pm = pm0 + fm + ((wgid % nig) % gsz), pn = pn0 + (wgid % nig) / gsz;
        u.aP = A + (size_t)pm * ars; u.bP = B + (size_t)pn * brs; u.r0 = pm * BM; u.c0 = pn * BM; u.co = 0; u.ldc = 0;
    }
};

template <class Epi, class Sched>
__device__ __forceinline__ void gemm_phase(LAS unsigned char* lds, const Gemm g, const Sched& S, const Epi& E) {
    int tid_ = threadIdx.x; asm volatile("" : "+v"(tid_));
    const int tid = tid_, wid = __builtin_amdgcn_readfirstlane(tid >> 6), lane = tid & 63, wr = wid >> 2, wc = wid & 3, fr = lane & 15, fq = lane >> 4;
    const int K = g.K, nt = K / BK;
    unsigned voffA[2], voffB[2];
#pragma unroll
    for (int i = 0; i < 2; ++i) { int R, C; stage_rc(tid * 16 + i * 8192, R, C); const int Rb = Epi::CH64 ? (64 * (R >> 5) + perm32(R & 31)) : Epi::PERM ? ((R & ~31) + perm32(R & 31)) : R;
        voffA[i] = (unsigned)(R * g.lda + C) * 2u; voffB[i] = (unsigned)(Rb * g.ldb + C) * 2u; }
    const size_t kstep = (size_t)(BK * 2);
    const size_t hstepA = (size_t)HALF * g.lda * 2, hstepB = (size_t)(Epi::CH64 ? 32 : HALF) * g.ldb * 2;
    const unsigned ldsw = (unsigned)wid * 1024u;
    const int aoff = lds_byte(wr * 64 + fr, fq * 8), boff = lds_byte(wc * 32 + fr, fq * 8);
#define PG8_SA(b, h) (((b) * 2 + (h)) * HTB)
#define PG8_SB(b, h) ((4 + (b) * 2 + (h)) * HTB)
#define PG8_STAGE(bufoff, gbase, voff) do { const char* _gb = (const char*)(gbase); asm volatile("" : "+s"(_gb)); _Pragma("unroll") for (int _i = 0; _i < 2; ++_i) \
        __builtin_amdgcn_global_load_lds((const unsigned*)(_gb + (voff)[_i]), (LAS unsigned*)(lds + (bufoff) + ldsw + _i * 8192), 16, 0, 0); } while (0)
#define PG8_LDA(dst, b, h) do { _Pragma("unroll") for (int m = 0; m < 4; ++m) _Pragma("unroll") for (int k = 0; k < 2; ++k) dst[m][k] = *(const LAS bf16x8*)(lds + PG8_SA(b, h) + aoff + m * 2048 + k * 1024); } while (0)
#define PG8_LDB(dst, b, h) do { _Pragma("unroll") for (int n = 0; n < 2; ++n) _Pragma("unroll") for (int k = 0; k < 2; ++k) dst[n][k] = *(const LAS bf16x8*)(lds + PG8_SB(b, h) + boff + n * 2048 + k * 1024); } while (0)
#define PG8_MMA(ai, bj, At, Bt) do { __builtin_amdgcn_s_setprio(1); _Pragma("unroll") for (int m = 0; m < 4; ++m) _Pragma("unroll") for (int n = 0; n < 2; ++n) _Pragma("unroll") for (int k = 0; k < 2; ++k) \
        acc[ai][bj][m][n] = __builtin_amdgcn_mfma_f32_16x16x32_bf16(Bt[n][k], At[m][k], acc[ai][bj][m][n], 0, 0, 0); __builtin_amdgcn_s_setprio(0); } while (0)
#define PG8_WAIT_V(n) asm volatile("s_waitcnt vmcnt(" #n ")" ::: "memory")
#define PG8_WAIT_L(n) asm volatile("s_waitcnt lgkmcnt(" #n ")" ::: "memory")
#define PG8_BAR __builtin_amdgcn_s_barrier()
#define PG8_SCHED __builtin_amdgcn_sched_barrier(0)
    Unit cur, nxt; int ui = 0;
    if (!S.next(0, cur)) return;
    f32x4 acc[2][2][4][2];
#pragma unroll
    for (int a = 0; a < 2; ++a)
#pragma unroll
        for (int b = 0; b < 2; ++b)
#pragma unroll
            for (int m = 0; m < 4; ++m)
#pragma unroll
                for (int n = 0; n < 2; ++n) acc[a][b][m][n] = (f32x4){0.f, 0.f, 0.f, 0.f};
    bf16x8 At[4][2], B0[2][2], B1[2][2];
    const char* cA = cur.aP; const char* cB = cur.bP;
    PG8_STAGE(PG8_SB(0, 0), cB, voffB); PG8_STAGE(PG8_SB(0, 1), cB + hstepB, voffB); PG8_STAGE(PG8_SA(0, 0), cA, voffA); PG8_STAGE(PG8_SA(0, 1), cA + hstepA, voffA);
    if (wr == 1) PG8_BAR;
    PG8_WAIT_V(2); PG8_BAR;
    PG8_STAGE(PG8_SB(1, 0), cB + kstep, voffB); PG8_STAGE(PG8_SA(1, 0), cA + kstep, voffA); PG8_STAGE(PG8_SB(1, 1), cB + hstepB + kstep, voffB);
    PG8_WAIT_V(6); PG8_BAR;
    for (;;) {
        const bool has_next = S.next(ui + 1, nxt);
        const char* nA = has_next ? nxt.aP : cA; const char* nB = has_next ? nxt.bP : cB;
#pragma unroll 1
        for (int t = 0; t < nt; t += 2) {
            const bool last = (t == nt - 2);
            const char* a1 = cA + (size_t)(t + 1) * kstep;
            const char* a2 = last ? nA : cA + (size_t)(t + 2) * kstep; const char* b2 = last ? nB : cB + (size_t)(t + 2) * kstep;
            const char* a3 = a2 + kstep; const char* b3 = b2 + kstep;
            if constexpr (Epi::HAS_MID) { if (t == (nt >> 1)) E.mid(acc, cur, wr, wc, fr, fq); }
            PG8_LDB(B0, 0, 0); PG8_LDB(B1, 0, 1); PG8_SCHED; PG8_LDA(At, 0, 0); PG8_STAGE(PG8_SA(1, 1), a1 + hstepA, voffA);
            PG8_WAIT_V(8); PG8_WAIT_L(0); PG8_BAR; PG8_MMA(0, 0, At, B0); PG8_MMA(0, 1, At, B1); PG8_BAR; PG8_SCHED;
            PG8_LDA(At, 0, 1); PG8_STAGE(PG8_SB(0, 0), b2, voffB); PG8_STAGE(PG8_SB(0, 1), b2 + hstepB, voffB); PG8_STAGE(PG8_SA(0, 0), a2, voffA);
            PG8_WAIT_V(8); PG8_WAIT_L(0); PG8_BAR; PG8_MMA(1, 0, At, B0); PG8_MMA(1, 1, At, B1); PG8_BAR; PG8_SCHED;
            PG8_LDB(B0, 1, 0); PG8_LDB(B1, 1, 1); PG8_SCHED; PG8_LDA(At, 1, 0); PG8_STAGE(PG8_SA(0, 1), a2 + hstepA, voffA);
            PG8_WAIT_V(8); PG8_WAIT_L(0); PG8_BAR; PG8_MMA(0, 0, At, B0); PG8_MMA(0, 1, At, B1); PG8_BAR; PG8_SCHED;
            PG8_LDA(At, 1, 1); PG8_STAGE(PG8_SB(1, 0), b3, voffB); PG8_STAGE(PG8_SB(1, 1), b3 + hstepB, voffB); PG8_STAGE(PG8_SA(1, 0), a3, voffA);
            PG8_WAIT_V(8); PG8_WAIT_L(0); PG8_BAR; PG8_MMA(1, 0, At, B0); PG8_MMA(1, 1, At, B1); PG8_BAR; PG8_SCHED;
        }
        if (wr == 0) PG8_BAR;
        E(acc, cur, wr, wc, fr, fq);
        if constexpr (Epi::PROBE2) E(acc, cur, wr, wc, fr, fq);
        if (!has_next) break;
#pragma unroll
        for (int a = 0; a < 2; ++a)
#pragma unroll
            for (int b = 0; b < 2; ++b)
#pragma unroll
                for (int m = 0; m < 4; ++m)
#pragma unroll
                    for (int n = 0; n < 2; ++n) acc[a][b][m][n] = (f32x4){0.f, 0.f, 0.f, 0.f};
        cur = nxt; cA = nA; cB = nB; ++ui;
        if (wr == 1) PG8_BAR;
    }
    PG8_WAIT_V(0);
    PG8_BAR;
#undef PG8_SA
#undef PG8_SB
#undef PG8_STAGE
#undef PG8_LDA
#undef PG8_LDB
#undef PG8_MMA
#undef PG8_WAIT_V
#undef PG8_WAIT_L
#undef PG8_BAR
#undef PG8_SCHED
}
}
using pg8::Unit;


struct EpiIn {
    static constexpr bool PERM = true, HAS_MID = false, PROBE2 = false, CH64 = true;
    bf16_t* P; bf16_t* QN; bf16_t* KC; float* ock; const float* gq; const float* gk; const float* RT; int l; unsigned char* GN; unsigned char* ZN;
    __device__ __forceinline__ void operator()(const f32x4 (&acc)[2][2][4][2], const Unit& u, int wr, int wc, int fr, int fq) const {
        const int pn = u.c0 >> 8;
        const int row0 = u.r0 + wr * 64 + fr;
        if (pn >= 8 && pn < 16) {
            const bool isq = pn < 12, smp = u.r0 >= NPROMPT;
            const int hc = ((u.c0 - (isq ? C_Q : C_K)) >> 6) + wc;
            const float* gp = (isq ? gq : gk) + 8 * fq;
            const f32x4 g00 = *(const f32x4*)gp, g01 = *(const f32x4*)(gp + 4), g10 = *(const f32x4*)(gp + 32), g11 = *(const f32x4*)(gp + 36);
            const bool isx2 = fq >= 2; const int jb = 8 * (fq & 1);
#pragma unroll
            for (int ai = 0; ai < 2; ++ai)
#pragma unroll
                for (int m = 0; m < 4; ++m) { int rowi = row0 + ai * 128 + m * 16; asm volatile("" : "+v"(rowi) :: "memory");
                    f32x4 y[2][2] = {{acc[ai][0][m][0], acc[ai][0][m][1]}, {acc[ai][1][m][0], acc[ai][1][m][1]}};
                    float ss = 0.f;
#pragma unroll
                    for (int a_ = 0; a_ < 2; ++a_)
#pragma unroll
                        for (int b_ = 0; b_ < 2; ++b_) ss += (y[a_][b_][0] * y[a_][b_][0] + y[a_][b_][1] * y[a_][b_][1]) + (y[a_][b_][2] * y[a_][b_][2] + y[a_][b_][3] * y[a_][b_][3]);
                    ss += __shfl_xor(ss, 16); ss += __shfl_xor(ss, 32);
                    const float rs = 1.0f / sqrtf(ss * (1.0f / 64.0f) + EPS);
                    y[0][0] = y[0][0] * rs * g00; y[0][1] = y[0][1] * rs * g01; y[1][0] = y[1][0] * rs * g10; y[1][1] = y[1][1] * rs * g11;
                    int b, n, Nq, Nk, koff; size_t base;
                    if (!smp) { b = rowi >> 8; n = rowi & 255; Nq = PSEQ; Nk = PSEQ; koff = 0; base = 0; }
                    else { const int r2 = rowi - NPROMPT; b = r2 >> 12; n = r2 & 4095; Nq = SSEQ; Nk = SNK; koff = PAST; base = (size_t)PB * 16 * PSEQ * 64; }
                    if (smp) {
                        const float* tr = RT + (n >> 6) * 16 + jb; const float* tc = RT + (n & 63) * 16 + jb;
#pragma unroll
                        for (int a_ = 0; a_ < 2; ++a_) { const float* tp = a_ ? tc : tr;
#pragma unroll
                            for (int b_ = 0; b_ < 2; ++b_) { const f32x4 c4 = *(const f32x4*)(tp + 4 * b_), s4 = *(const f32x4*)(tp + 1024 + 4 * b_);
#pragma unroll
                                for (int j = 0; j < 4; ++j) { const float pr = __shfl_xor(y[a_][b_][j], 32); y[a_][b_][j] = isx2 ? (y[a_][b_][j] * c4[j] + pr * s4[j]) : (y[a_][b_][j] * c4[j] - pr * s4[j]); } } }
                    }
                    if (isq) { bf16_t* dst = QN + base + ((size_t)(b * 16 + hc) * Nq + n) * 64 + 8 * fq;
#pragma unroll
                        for (int a_ = 0; a_ < 2; ++a_) { const f32x4 v0 = y[a_][0] * QSCALE, v1 = y[a_][1] * QSCALE;
                            u32x4 w; w.x = cvtpk(v0[0], v0[1]); w.y = cvtpk(v0[2], v0[3]); w.z = cvtpk(v1[0], v1[1]); w.w = cvtpk(v1[2], v1[3]); *(u32x4*)(dst + 32 * a_) = w; } }
                    else { bf16_t* dst = KC + base + ((size_t)(b * 16 + hc) * Nk + koff + n) * 64 + 8 * fq;
#pragma unroll
                        for (int a_ = 0; a_ < 2; ++a_) { const f32x4 v0 = y[a_][0], v1 = y[a_][1];
                            u32x4 w; w.x = cvtpk(v0[0], v0[1]); w.y = cvtpk(v0[2], v0[3]); w.z = cvtpk(v1[0], v1[1]); w.w = cvtpk(v1[2], v1[3]); *(u32x4*)(dst + 32 * a_) = w; }
                        if (!smp) { float* o = ock + ((size_t)(b * DEPTH + l) * PSEQ + n) * 1024 + hc * 64 + 8 * fq;
#pragma unroll
                            for (int a_ = 0; a_ < 2; ++a_) { *(f32x4*)(o + 32 * a_) = y[a_][0]; *(f32x4*)(o + 32 * a_ + 4) = y[a_][1]; } } }
                    asm volatile("" ::: "memory"); }
            return;
        }
        const int mode = (pn < 4) ? 0 : (pn < 8) ? 1 : (pn < 20) ? 0 : (pn < 24) ? 1 : 2;
        const int col0 = u.c0 + wc * 64 + 8 * fq;
        const bool native = (pn >= 4 && pn < 8) || pn >= 24;
        unsigned char* nbase = (pn >= 24) ? GN + nat_off((u.r0 >> 8) * 16 + (pn - 24), 0, 0, 0, wr * 4 + wc, 0) : ZN + nat_off((u.r0 >> 8) * 4 + (pn - 4), 0, 0, 0, wr * 4 + wc, 0);
#pragma unroll
        for (int ai = 0; ai < 2; ++ai)
#pragma unroll
            for (int m = 0; m < 4; ++m) { int rowi = row0 + ai * 128 + m * 16; asm volatile("" : "+v"(rowi) :: "memory"); bf16_t* rowp = P + (size_t)rowi * INC + col0;
#pragma unroll
                for (int bj = 0; bj < 2; ++bj) { f32x4 v0 = acc[ai][bj][m][0], v1 = acc[ai][bj][m][1];
                    if (mode == 1) {
#pragma unroll
                        for (int j = 0; j < 4; ++j) { v0[j] = siluf_(v0[j]); v1[j] = siluf_(v1[j]); } }
                    else if (mode == 2) {
#pragma unroll
                        for (int j = 0; j < 4; ++j) { v0[j] = sigmoidf_(v0[j]); v1[j] = sigmoidf_(v1[j]); } }
                    u32x4 w; w.x = cvtpk(v0[0], v0[1]); w.y = cvtpk(v0[2], v0[3]); w.z = cvtpk(v1[0], v1[1]); w.w = cvtpk(v1[2], v1[3]);
                    if (native) { unsigned vo = (unsigned)(fr + 16 * fq) * 16u; asm volatile("" : "+v"(vo)); __builtin_nontemporal_store(w, (u32x4*)(nbase + (size_t)((ai * 4 + m) * 2 + bj) * 8192 + vo)); } else __builtin_nontemporal_store(w, (u32x4*)(rowp + bj * 32)); }
                asm volatile("" ::: "memory"); }
    }
};
struct EpiStore {
    static constexpr bool PERM = true, HAS_MID = false, PROBE2 = false, CH64 = false;
    bf16_t* O;
    __device__ __forceinline__ void operator()(const f32x4 (&acc)[2][2][4][2], const Unit& u, int wr, int wc, int fr, int fq) const {
        bf16_t* base = O + u.co + (size_t)(wr * 64 + fr) * u.ldc + wc * 32 + 8 * fq;
#pragma unroll
        for (int ai = 0; ai < 2; ++ai)
#pragma unroll
            for (int m = 0; m < 4; ++m) { int rowi = ai * 128 + m * 16; asm volatile("" : "+v"(rowi) :: "memory"); bf16_t* rowp = base + (size_t)rowi * u.ldc;
#pragma unroll
                for (int bj = 0; bj < 2; ++bj) { const f32x4 v0 = acc[ai][bj][m][0], v1 = acc[ai][bj][m][1];
                    u32x4 w; w.x = cvtpk(v0[0], v0[1]); w.y = cvtpk(v0[2], v0[3]); w.z = cvtpk(v1[0], v1[1]); w.w = cvtpk(v1[2], v1[3]);
                    *(u32x4*)(rowp + bj * 128) = w; }
                asm volatile("" ::: "memory"); }
    }
};
struct EpiPos {
    static constexpr bool PERM = true, HAS_MID = false, PROBE2 = false, CH64 = true;
    const unsigned char* ZN; bf16_t* Y;
    __device__ __forceinline__ void operator()(const f32x4 (&acc)[2][2][4][2], const Unit& u, int wr, int wc, int fr, int fq) const {
        const int row0 = u.r0 + wr * 64 + fr, col0 = u.c0 + wc * 64 + 8 * fq;
        const unsigned char* nb = ZN + nat_off((u.r0 >> 8) * 4 + (u.c0 >> 8), 0, 0, 0, wr * 4 + wc, 0);
#pragma unroll
        for (int ai = 0; ai < 2; ++ai)
#pragma unroll
            for (int m = 0; m < 4; ++m) { int rowi = row0 + ai * 128 + m * 16; asm volatile("" : "+v"(rowi) :: "memory"); const size_t row = (size_t)rowi;
#pragma unroll
                for (int bj = 0; bj < 2; ++bj) { const f32x4 v0 = acc[ai][bj][m][0], v1 = acc[ai][bj][m][1];
                    unsigned vo = (unsigned)(fr + 16 * fq) * 16u; asm volatile("" : "+v"(vo)); const u32x4 z = *(const u32x4*)(nb + (size_t)((ai * 4 + m) * 2 + bj) * 8192 + vo); float zf[8]; unpack8(z, zf);
                    u32x4 w; w.x = cvtpk(v0[0] * zf[0], v0[1] * zf[1]); w.y = cvtpk(v0[2] * zf[2], v0[3] * zf[3]); w.z = cvtpk(v1[0] * zf[4], v1[1] * zf[5]); w.w = cvtpk(v1[2] * zf[6], v1[3] * zf[7]);
                    *(u32x4*)(Y + row * D + col0 + bj * 32) = w; }
                asm volatile("" ::: "memory"); }
    }
};
struct EpiMerge {
    static constexpr bool PERM = true, HAS_MID = true, PROBE2 = false, CH64 = true;
    const unsigned char* GN; bf16_t* MG;
    __device__ __forceinline__ void mid(f32x4 (&acc)[2][2][4][2], const Unit& u, int wr, int wc, int fr, int fq) const {
        const unsigned char* gfb = GN + nat_off((u.r0 >> 8) * 16 + (u.c0 >> 8), 0, 0, 0, wr * 4 + wc, 0); const unsigned char* gab = gfb + (size_t)8 * 131072;
        unsigned vo = (unsigned)(fr + 16 * fq) * 16u; asm volatile("" : "+v"(vo) :: "memory");
        u32x4 ra[2][2][2], rb[2][2][2];
#define HOOK_LD(buf, b) do { _Pragma("unroll") for (int q_ = 0; q_ < 2; ++q_) _Pragma("unroll") for (int bj = 0; bj < 2; ++bj) { const size_t o = (size_t)(((b) * 2 + q_) * 2 + bj) * 8192; \
            ra[buf][q_][bj] = *(const u32x4*)(gfb + o + vo); rb[buf][q_][bj] = *(const u32x4*)(gab + o + vo); } } while (0)
#define HOOK_MUL(buf, b) do { _Pragma("unroll") for (int q_ = 0; q_ < 2; ++q_) { const int g_ = (b) * 2 + q_, ai = g_ >> 2, m = g_ & 3; _Pragma("unroll") for (int bj = 0; bj < 2; ++bj) { \
            float gf[8], ga[8]; unpack8(ra[buf][q_][bj], gf); unpack8(rb[buf][q_][bj], ga); \
            _Pragma("unroll") for (int j = 0; j < 4; ++j) { acc[ai][bj][m][0][j] *= gf[j] * __builtin_amdgcn_rcpf(ga[j]); acc[ai][bj][m][1][j] *= gf[4 + j] * __builtin_amdgcn_rcpf(ga[4 + j]); } } } } while (0)
        HOOK_LD(0, 0); HOOK_LD(1, 1); __builtin_amdgcn_sched_barrier(0);
        HOOK_MUL(0, 0); __builtin_amdgcn_sched_barrier(0); HOOK_LD(0, 2); __builtin_amdgcn_sched_barrier(0);
        HOOK_MUL(1, 1); __builtin_amdgcn_sched_barrier(0); HOOK_LD(1, 3); __builtin_amdgcn_sched_barrier(0);
        HOOK_MUL(0, 2); __builtin_amdgcn_sched_barrier(0);
        HOOK_MUL(1, 3);
#undef HOOK_LD
#undef HOOK_MUL
        asm volatile("" ::: "memory");
    }
    __device__ __forceinline__ void operator()(const f32x4 (&acc)[2][2][4][2], const Unit& u, int wr, int wc, int fr, int fq) const {
        const int row0 = u.r0 + wr * 64 + fr, col0 = u.c0 + wc * 64 + 8 * fq;
        const unsigned char* gab = GN + nat_off((u.r0 >> 8) * 16 + 8 + (u.c0 >> 8), 0, 0, 0, wr * 4 + wc, 0);
#pragma unroll
        for (int ai = 0; ai < 2; ++ai)
#pragma unroll
            for (int m = 0; m < 4; ++m) { int rowi = row0 + ai * 128 + m * 16; asm volatile("" : "+v"(rowi) :: "memory"); const size_t row = (size_t)rowi;
#pragma unroll
                for (int bj = 0; bj < 2; ++bj) { const f32x4 v0 = acc[ai][bj][m][0], v1 = acc[ai][bj][m][1];
                    unsigned vo = (unsigned)(fr + 16 * fq) * 16u; asm volatile("" : "+v"(vo)); const u32x4 b = *(const u32x4*)(gab + (size_t)((ai * 4 + m) * 2 + bj) * 8192 + vo); float ga[8]; unpack8(b, ga);
                    u32x4 w; w.x = cvtpk(v0[0] * ga[0], v0[1] * ga[1]); w.y = cvtpk(v0[2] * ga[2], v0[3] * ga[3]); w.z = cvtpk(v1[0] * ga[4], v1[1] * ga[5]); w.w = cvtpk(v1[2] * ga[6], v1[3] * ga[7]);
                    *(u32x4*)(MG + row * D + col0 + bj * 32) = w; }
                asm volatile("" ::: "memory"); }
    }
};
struct EpiOut {
    static constexpr bool PERM = false, HAS_MID = false, PROBE2 = false, CH64 = false;
    const float* xp; const float* xs; float* out; const float* mod;
    __device__ __forceinline__ void operator()(const f32x4 (&acc)[2][2][4][2], const Unit& u, int wr, int wc, int fr, int fq) const {
        const int row0 = u.r0 + wr * 64 + fr, col0 = u.c0 + wc * 32 + 4 * fq;
        const int cv = (u.r0 < NPROMPT) ? 0 : 1 + ((u.r0 - NPROMPT) >> 12);
        const float* gate = mod + cv * 6144 + 4096 + col0;
        const float* xin = (u.r0 < NPROMPT) ? xp : xs - (size_t)NPROMPT * D;
        f32x4 gv[2][2];
#pragma unroll
        for (int bj = 0; bj < 2; ++bj)
#pragma unroll
            for (int n = 0; n < 2; ++n) gv[bj][n] = *(const f32x4*)(gate + bj * 128 + n * 16);
        f32x4 xn[2][2];
        { int rowi = row0; asm volatile("" : "+v"(rowi) :: "memory"); const size_t off = (size_t)rowi * D + col0;
#pragma unroll
          for (int bj = 0; bj < 2; ++bj)
#pragma unroll
              for (int n = 0; n < 2; ++n) xn[bj][n] = *(const f32x4*)(xin + off + bj * 128 + n * 16); }
#pragma unroll
        for (int g = 0; g < 8; ++g) { const int ai = g >> 2, m = g & 3;
            f32x4 xo[2][2];
#pragma unroll
            for (int bj = 0; bj < 2; ++bj)
#pragma unroll
                for (int n = 0; n < 2; ++n) xo[bj][n] = xn[bj][n];
            if (g < 7) { int rowi = row0 + ((g + 1) >> 2) * 128 + ((g + 1) & 3) * 16; asm volatile("" : "+v"(rowi)); const size_t off = (size_t)rowi * D + col0;
#pragma unroll
                for (int bj = 0; bj < 2; ++bj)
#pragma unroll
                    for (int n = 0; n < 2; ++n) xn[bj][n] = *(const f32x4*)(xin + off + bj * 128 + n * 16); }
            __builtin_amdgcn_sched_barrier(0);
            { int rowi = row0 + ai * 128 + m * 16; asm volatile("" : "+v"(rowi)); const size_t off = (size_t)rowi * D + col0;
#pragma unroll
              for (int bj = 0; bj < 2; ++bj)
#pragma unroll
                  for (int n = 0; n < 2; ++n) *(f32x4*)(out + off + bj * 128 + n * 16) = xo[bj][n] + gv[bj][n] * acc[ai][bj][m][n]; }
            __builtin_amdgcn_sched_barrier(0); }
        asm volatile("" ::: "memory");
    }
};

struct MapChan {
    const char* CST; const char* P;
    __device__ __forceinline__ void operator()(int L, Unit& u) const {
        int b, g, pm, pn, N1, tok0; size_t abt;
        if (L < 128) { b = L >> 3; g = (L >> 1) & 3; pm = L & 1; pn = 0; N1 = PSEQ; tok0 = b * PSEQ; abt = (size_t)b * 1024 * 512; }
        else { const int M_ = L - 128; b = M_ >> 7; g = (M_ >> 5) & 3; pm = (M_ >> 4) & 1; pn = M_ & 15; N1 = SSEQ; tok0 = NPROMPT + b * SSEQ; abt = (size_t)PB * 1024 * 512 + (size_t)b * 1024 * 8192; }
        u.aP = CST + (size_t)pm * 256 * 256 * 2;
        u.bP = P + ((size_t)(tok0 + pn * 256) * INC + C_UF + g * 256) * 2;
        u.co = abt + (size_t)(g * 256) * (2 * N1) + (size_t)pm * N1 + pn * 256; u.ldc = 2 * N1; u.r0 = 0; u.c0 = 0;
    }
};
struct MapPosP {
    const char* T; const char* ABT;
    __device__ __forceinline__ void operator()(int L, Unit& u) const {
        const int b = L >> 2, pn = L & 3;
        u.aP = T; u.bP = ABT + ((size_t)b * 1024 * 512 + (size_t)pn * 256 * 512) * 2; u.r0 = b * PSEQ; u.c0 = pn * 256; u.co = 0; u.ldc = 0;
    }
};
struct MapPosS {
    const char* T; const char* FB;
    __device__ __forceinline__ void operator()(int L, Unit& u) const {
        const int b = L >> 6, pm = (L >> 2) & 15, pn = L & 3;
        u.aP = T + (size_t)pm * 256 * 4096 * 2; u.bP = FB + ((size_t)b * 1024 * 4096 + (size_t)pn * 256 * 4096) * 2;
        u.r0 = NPROMPT + b * SSEQ + pm * 256; u.c0 = pn * 256; u.co = 0; u.ldc = 0;
    }
};

struct Args {
    const float* in[20]; float* out; unsigned char* ws; int ph_lo, ph_hi;
};

__device__ __forceinline__ void transpose_item(const float* W, int N, bf16_t* WT, int ldwt, int koff, LAS float* scr, int item, int lane) {
    const int nblk = N / 32, kb = item / nblk, nb = item % nblk, k0 = 64 * kb, n0 = 32 * nb;
#pragma unroll 8
    for (int i = 0; i < 32; ++i) { const int kk = 2 * i + (lane >> 5); scr[kk * 33 + (lane & 31)] = W[(size_t)(k0 + kk) * N + n0 + (lane & 31)]; }
    asm volatile("s_waitcnt lgkmcnt(0)" ::: "memory");
    const int c = lane & 7;
#pragma unroll
    for (int j = 0; j < 4; ++j) { const int n = (lane >> 3) + 8 * j; const LAS float* s = scr + (8 * c) * 33 + n;
        u32x4 o; o.x = cvtpk(s[0 * 33], s[1 * 33]); o.y = cvtpk(s[2 * 33], s[3 * 33]); o.z = cvtpk(s[4 * 33], s[5 * 33]); o.w = cvtpk(s[6 * 33], s[7 * 33]);
        *(u32x4*)(WT + (size_t)(n0 + n) * ldwt + koff + k0 + 8 * c) = o; }
    asm volatile("s_waitcnt lgkmcnt(0)" ::: "memory");
}

__device__ __forceinline__ void phase_pre0(const Args& a, LAS unsigned char* lds) {
    const int tid = threadIdx.x, lane = tid & 63, wave = __builtin_amdgcn_readfirstlane(tid >> 6), G = gridDim.x;
    unsigned char* ws = a.ws;
    {
        LAS float* scr = (LAS float*)(lds + wave * 16384);
        const int gw = blockIdx.x * 8 + wave, NGW = G * 8;
        constexpr int I_IN = 4 * 32 * 320, I_F = 4 * 16 * 64, I_O = 4 * 32 * 64, NIT = I_IN + 2 * I_F + I_O;
        bf16_t* WIN = (bf16_t*)(ws + WS_WIN); bf16_t* WM = (bf16_t*)(ws + WS_WM); bf16_t* WO = (bf16_t*)(ws + WS_WO);
        for (int it = gw; it < NIT; it += NGW) {
            int r = it;
            if (r < I_IN) { const int l = r / 10240, rr = r % 10240; transpose_item(a.in[6] + (size_t)l * D * INC, INC, WIN + (size_t)l * INC * D, D, 0, scr, rr, lane); continue; } r -= I_IN;
            if (r < I_F) { const int l = r / 1024, rr = r % 1024; transpose_item(a.in[7] + (size_t)l * 1024 * D, D, WM + (size_t)l * D * D, D, 0, scr, rr, lane); continue; } r -= I_F;
            if (r < I_F) { const int l = r / 1024, rr = r % 1024; transpose_item(a.in[8] + (size_t)l * 1024 * D, D, WM + (size_t)l * D * D, D, 1024, scr, rr, lane); continue; } r -= I_F;
            { const int l = r / 2048, rr = r % 2048; transpose_item(a.in[9] + (size_t)l * D * D, D, WO + (size_t)l * D * D, D, 0, scr, rr, lane); }
        }
    }
    __syncthreads();
    {
        LAS float* sc = (LAS float*)lds;
        float* MODP = (float*)(ws + WS_MODP);
        const float* wmod = a.in[10];
        for (int un = blockIdx.x; un < 768; un += G) {
            const int l = un / 192, part = (un / 12) % 16, jb = un % 12, j = jb * 512 + tid;
            __syncthreads();
            for (int idx = tid; idx < 640; idx += 512) { const int c = idx >> 7, i = idx & 127;
                const float v = (c == 0) ? a.in[5][part * 128 + i] : a.in[2][(c - 1) * D + part * 128 + i]; sc[idx] = siluf_(v); }
            __syncthreads();
            float s0 = 0.f, s1 = 0.f, s2 = 0.f, s3 = 0.f, s4 = 0.f;
            const float* wp = wmod + ((size_t)l * D + part * 128) * 6144 + j;
#pragma unroll 8
            for (int i = 0; i < 128; ++i) { const float w = wp[(size_t)i * 6144]; s0 += sc[i] * w; s1 += sc[128 + i] * w; s2 += sc[256 + i] * w; s3 += sc[384 + i] * w; s4 += sc[512 + i] * w; }
            float* o = MODP + ((size_t)(l * 16 + part) * 5) * 6144 + j;
            o[0] = s0; o[6144] = s1; o[2 * 6144] = s2; o[3 * 6144] = s3; o[4 * 6144] = s4;
        }
    }
    {
        const size_t gt = (size_t)blockIdx.x * 512 + tid, NT_ = (size_t)G * 512;
        bf16_t* T4 = (bf16_t*)(ws + WS_T4096); bf16_t* T2 = (bf16_t*)(ws + WS_TAB); bf16_t* CS = (bf16_t*)(ws + WS_TAB + 256 * 1024);
        for (size_t ch = gt; ch < (size_t)4096 * 512; ch += NT_) {
            const int k1 = (int)(ch >> 9), kk0 = (int)(ch & 511) * 8; float v[8];
#pragma unroll
            for (int e = 0; e < 8; ++e) { const int kk = kk0 + e, n1 = (kk <= 2048) ? kk : kk - 2048; const float fr_ = (float)((k1 * n1) & 4095) * (1.0f / 4096.0f);
                v[e] = (kk <= 2048) ? __builtin_amdgcn_cosf(fr_) * (1.0f / 64.0f) : -__builtin_amdgcn_sinf(fr_) * (1.0f / 64.0f); }
            u32x4 o; o.x = cvtpk(v[0], v[1]); o.y = cvtpk(v[2], v[3]); o.z = cvtpk(v[4], v[5]); o.w = cvtpk(v[6], v[7]);
            *(u32x4*)(T4 + ch * 8) = o;
        }
        for (size_t ch = gt; ch < (size_t)256 * 64; ch += NT_) {
            const int k1 = (int)(ch >> 6), kk0 = (int)(ch & 63) * 8; float v[8];
#pragma unroll
            for (int e = 0; e < 8; ++e) { const int kk = kk0 + e, n1 = kk & 255; const float fr_ = (float)((k1 * n1) & 255) * (1.0f / 256.0f);
                v[e] = (kk < 256) ? __builtin_amdgcn_cosf(fr_) * (1.0f / 16.0f) : -__builtin_amdgcn_sinf(fr_) * (1.0f / 16.0f); }
            u32x4 o; o.x = cvtpk(v[0], v[1]); o.y = cvtpk(v[2], v[3]); o.z = cvtpk(v[4], v[5]); o.w = cvtpk(v[6], v[7]);
            *(u32x4*)(T2 + ch * 8) = o;
        }
        for (size_t ch = gt; ch < (size_t)512 * 32; ch += NT_) {
            const int m = (int)(ch >> 5), c0 = (int)(ch & 31) * 8, k2 = m & 255; float v[8];
#pragma unroll
            for (int e = 0; e < 8; ++e) { const float fr_ = (float)((k2 * (c0 + e)) & 255) * (1.0f / 256.0f);
                v[e] = (m < 256) ? __builtin_amdgcn_cosf(fr_) * (1.0f / 16.0f) : __builtin_amdgcn_sinf(fr_) * (1.0f / 16.0f); }
            u32x4 o; o.x = cvtpk(v[0], v[1]); o.y = cvtpk(v[2], v[3]); o.z = cvtpk(v[4], v[5]); o.w = cvtpk(v[6], v[7]);
            *(u32x4*)(CS + ch * 8) = o;
        }
        float* RT = (float*)(ws + WS_TAB + 512 * 1024);
        if (gt < 1024) { const int pos = (int)(gt >> 4), j = (int)(gt & 15); float sn_, cs_; sincosf((float)pos * exp2f(-(float)j * (13.287712379549449f / 16.0f)), &sn_, &cs_); RT[gt] = cs_; RT[1024 + gt] = sn_; }
    }
}
__device__ __forceinline__ void phase_pre1(const Args& a) {
    const size_t gt = (size_t)blockIdx.x * 512 + threadIdx.x, NT_ = (size_t)gridDim.x * 512;
    const float* MODP = (const float*)(a.ws + WS_MODP); float* MOD = (float*)(a.ws + WS_MOD);
    for (size_t idx = gt; idx < (size_t)4 * 5 * 6144; idx += NT_) {
        const int l = (int)(idx / 30720), c = (int)((idx / 6144) % 5), j = (int)(idx % 6144);
        float s = a.in[11][l * 6144 + j];
#pragma unroll
        for (int p = 0; p < 16; ++p) s += MODP[((size_t)(l * 16 + p) * 5 + c) * 6144 + j];
        MOD[idx] = s;
    }
    if (gt < 4) { const int l = (int)gt; float s1 = 0.f, s2 = 0.f;
        for (int i = 0; i < 64; ++i) { s1 += a.in[16][l * 64 + i] * a.in[17][l * 64 + i]; s2 += a.in[18][l * 64 + i] * a.in[19][l * 64 + i]; }
        const float lam_init = 0.8f - 0.6f * expf(-0.3f * (float)l);
        MOD[4 * 5 * 6144 + l] = expf(s1) - expf(s2) + lam_init; }
}
__device__ __forceinline__ void phase_norm(const Args& a, int l) {
    int tid_ = threadIdx.x; asm volatile("" : "+v"(tid_));
    const int tid = tid_, lane = tid & 63, wave = tid >> 6, G = gridDim.x;
    const int gw = blockIdx.x * 8 + wave, NGW = G * 8;
    const float* MOD = (const float*)(a.ws + WS_MOD) + (size_t)l * 5 * 6144;
    const float* gn = a.in[12] + l * D;
    bf16_t* H = (bf16_t*)(a.ws + WS_H);
    for (int row = gw; row < NTOK; row += NGW) {
        const float* xrow = (l == 0) ? ((row < NPROMPT) ? a.in[0] + (size_t)row * D : a.in[1] + (size_t)(row - NPROMPT) * D) : a.out + (size_t)row * D;
        const int cv = (row < NPROMPT) ? 0 : 1 + ((row - NPROMPT) >> 12);
        const f32x4* xr = (const f32x4*)xrow + lane;
        f32x4 v[8]; float ss = 0.f;
#pragma unroll
        for (int j = 0; j < 8; ++j) { v[j] = xr[64 * j]; ss += (v[j].x * v[j].x + v[j].y * v[j].y) + (v[j].z * v[j].z + v[j].w * v[j].w); }
        const float rstd = 1.0f / sqrtf(wave_sum(ss) * (1.0f / D) + EPS);
        const float* sh = MOD + cv * 6144; const float* sc = sh + 2048;
#pragma unroll
        for (int j = 0; j < 8; ++j) { const int idx = (lane + 64 * j) * 4;
            const f32x4 g4 = *(const f32x4*)(gn + idx), s4 = *(const f32x4*)(sc + idx), h4 = *(const f32x4*)(sh + idx);
            const f32x4 o = v[j] * rstd * g4 * (s4 + 1.0f) + h4;
            u32x2 w; w.x = cvtpk(o.x, o.y); w.y = cvtpk(o.z, o.w);
            *(u32x2*)(H + (size_t)row * D + idx) = w; }
    }
    const size_t gt = (size_t)blockIdx.x * 512 + tid, NT_ = (size_t)G * 512;
    bf16_t* KCs = (bf16_t*)(a.ws + WS_KC) + (size_t)PB * 8 * 2 * PSEQ * 64;
    bf16_t* VTs = (bf16_t*)(a.ws + WS_VT) + (size_t)PB * 8 * 128 * PSEQ;
    for (size_t ch = gt; ch < (size_t)SB * PAST * 128; ch += NT_) {
        const int c8 = (int)(ch & 7), hc = (int)((ch >> 3) & 15), key = (int)((ch >> 7) & 511), b = (int)(ch >> 16);
        const float* src = a.in[3] + (((size_t)(b * DEPTH + l) * PAST + key) * 1024 + hc * 64 + c8 * 8);
        const f32x4 x0 = *(const f32x4*)src, x1 = *(const f32x4*)(src + 4);
        u32x4 w; w.x = cvtpk(x0.x, x0.y); w.y = cvtpk(x0.z, x0.w); w.z = cvtpk(x1.x, x1.y); w.w = cvtpk(x1.z, x1.w);
        *(u32x4*)(KCs + (((size_t)(b * 16 + hc)) * SNK + key) * 64 + c8 * 8) = w;
    }
    for (size_t ch = gt; ch < (size_t)SB * 8 * 64 * 128; ch += NT_) {
        const int d = (int)(ch & 127), pc = (int)((ch >> 7) & 63), h = (int)((ch >> 13) & 7), b = (int)(ch >> 16);
        const int s = pc >> 1, hf = pc & 1; float v[8];
#pragma unroll
        for (int i = 0; i < 8; ++i) { const int key = 16 * s + 8 * (i >> 2) + 4 * hf + (i & 3);
            v[i] = a.in[4][((size_t)(b * DEPTH + l) * PAST + key) * 1024 + h * 128 + d]; }
        u32x4 w; w.x = cvtpk(v[0], v[1]); w.y = cvtpk(v[2], v[3]); w.z = cvtpk(v[4], v[5]); w.w = cvtpk(v[6], v[7]);
        *(u32x4*)(VTs + ((size_t)(b * 8 + h) * 128 + d) * SNK + pc * 8) = w;
    }
}
__device__ __forceinline__ void phase_prep(const Args& a, int l, LAS unsigned char* lds) {
    int tid_ = threadIdx.x; asm volatile("" : "+v"(tid_));
    const int tid = tid_, lane = tid & 63, wave = tid >> 6, G = gridDim.x;
    const int gw = blockIdx.x * 8 + wave, NGW = G * 8;
    const bf16_t* P = (const bf16_t*)(a.ws + WS_P);
    bf16_t* QN = (bf16_t*)(a.ws + WS_QN); bf16_t* KC = (bf16_t*)(a.ws + WS_KC); bf16_t* VT = (bf16_t*)(a.ws + WS_VT);
    float* ock = a.out + (size_t)41943040; float* ocv = a.out + (size_t)58720256;
    for (int item = blockIdx.x; item < 2560; item += G) {
        const int tb = item >> 3, h = item & 7, tok0 = tb * 64;
        const bool smp = tok0 >= NPROMPT;
        int b, n0, Nk, koff; size_t vbase;
        if (!smp) { b = tok0 >> 8; n0 = tok0 & 255; Nk = PSEQ; koff = 0; vbase = 0; }
        else { const int r2 = tok0 - NPROMPT; b = r2 >> 12; n0 = r2 & 4095; Nk = SNK; koff = PAST; vbase = (size_t)PB * 8 * 128 * PSEQ; }
        __syncthreads();
#pragma unroll
        for (int i = 0; i < 2; ++i) { const int piece = tid + 512 * i, r = piece >> 4, cc = piece & 15;
            const u32x4 v = *(const u32x4*)(P + (size_t)(tok0 + r) * INC + C_V + h * 128 + cc * 8);
            *(LAS u32x4*)(lds + r * 272 + cc * 16) = v;
            if (!smp) { float f[8]; unpack8(v, f); float* o = ocv + ((size_t)(b * DEPTH + l) * PSEQ + n0 + r) * 1024 + h * 128 + cc * 8;
                *(f32x4*)o = (f32x4){f[0], f[1], f[2], f[3]}; *(f32x4*)(o + 4) = (f32x4){f[4], f[5], f[6], f[7]}; } }
        __syncthreads();
#pragma unroll
        for (int i = 0; i < 2; ++i) { const int oc = tid + 512 * i, d = oc >> 3, pc = oc & 7, s = pc >> 1, hf = pc & 1;
            unsigned short e[8];
#pragma unroll
            for (int j = 0; j < 8; ++j) { const int key = 16 * s + 8 * (j >> 2) + 4 * hf + (j & 3); e[j] = *(const LAS unsigned short*)(lds + key * 272 + d * 2); }
            u32x4 w; w.x = e[0] | ((unsigned)e[1] << 16); w.y = e[2] | ((unsigned)e[3] << 16); w.z = e[4] | ((unsigned)e[5] << 16); w.w = e[6] | ((unsigned)e[7] << 16);
            *(u32x4*)(VT + vbase + ((size_t)(b * 8 + h) * 128 + d) * Nk + koff + n0 + pc * 8) = w; }
    }
    __syncthreads();
}

__device__ __forceinline__ void phase_fold(const Args& a) {
    int tid_ = threadIdx.x; asm volatile("" : "+v"(tid_));
    const size_t gt = (size_t)blockIdx.x * 512 + tid_, NT_ = (size_t)gridDim.x * 512;
    const bf16_t* ABTs = (const bf16_t*)(a.ws + WS_ABT) + (size_t)PB * 1024 * 512;
    bf16_t* FB = (bf16_t*)(a.ws + WS_T4096 + 32 * MiB);
    for (size_t ch = gt; ch < (size_t)SB * 1024 * 512; ch += NT_) {
        const int kk0 = (int)(ch & 511) * 8; const size_t row = ch >> 9;
        const bf16_t* A = ABTs + row * 8192; const bf16_t* B = A + 4096; float v[8];
#pragma unroll
        for (int e = 0; e < 8; ++e) { const int kk = kk0 + e;
            if (kk <= 2048) { float x = bf2f(A[kk]); if (kk != 0 && kk != 2048) x += bf2f(A[4096 - kk]); v[e] = x; }
            else { const int n = kk - 2048; v[e] = bf2f(B[n]) - bf2f(B[4096 - n]); } }
        u32x4 o; o.x = cvtpk(v[0], v[1]); o.y = cvtpk(v[2], v[3]); o.z = cvtpk(v[4], v[5]); o.w = cvtpk(v[6], v[7]);
        *(u32x4*)(FB + row * 4096 + kk0) = o;
    }
}

__device__ __forceinline__ void attn_item(LAS unsigned char* lds, const bf16_t* Q, int Nq, const bf16_t* Kc, const bf16_t* Vt, int Nk, int q0,
                                          float lam, float onorm, const float* gsub, const bf16_t* za, bf16_t* Yo) {
    int tid_ = threadIdx.x; asm volatile("" : "+v"(tid_));
    const int tid = tid_, lane = tid & 63, wave = __builtin_amdgcn_readfirstlane(tid >> 6), r32 = lane & 31, hi = lane >> 5, c = wave >> 2, qs = wave & 3;
    bf16x8 qr[4];
    { const bf16_t* qp = Q + ((size_t)c * Nq + q0 + qs * 32 + r32) * 64 + hi * 8;
#pragma unroll
      for (int d0 = 0; d0 < 4; ++d0) qr[d0] = *(const bf16x8*)(qp + d0 * 16); }
    const int srow = wave * 8 + (lane >> 3), sch = (lane & 7) ^ ((srow >> 1) & 7);
    const bf16_t* k0src = Kc + (size_t)srow * 64 + sch * 8; const bf16_t* k1src = k0src + (size_t)Nk * 64;
    const bf16_t* v0src = Vt + (size_t)srow * Nk + sch * 8; const bf16_t* v1src = v0src + (size_t)64 * Nk;
    const int wpiece = wave * 1024;
#define ATT_DMA(stgoff, tt) do { \
        __builtin_amdgcn_global_load_lds((const unsigned*)(k0src + (size_t)(tt) * 4096), (LAS unsigned*)(lds + (stgoff) + wpiece), 16, 0, 0); \
        __builtin_amdgcn_global_load_lds((const unsigned*)(k1src + (size_t)(tt) * 4096), (LAS unsigned*)(lds + (stgoff) + 8192 + wpiece), 16, 0, 0); \
        __builtin_amdgcn_global_load_lds((const unsigned*)(v0src + (size_t)(tt) * 64), (LAS unsigned*)(lds + (stgoff) + 16384 + wpiece), 16, 0, 0); \
        __builtin_amdgcn_global_load_lds((const unsigned*)(v1src + (size_t)(tt) * 64), (LAS unsigned*)(lds + (stgoff) + 24576 + wpiece), 16, 0, 0); } while (0)
    const int swz = (r32 >> 1) & 7; int xo[4];
#pragma unroll
    for (int j = 0; j < 4; ++j) xo[j] = ((2 * j + hi) ^ swz) * 16;
    const int kro = c * 8192 + r32 * 128, vro = 16384 + r32 * 128;
    const int NT = Nk >> 6;
    ATT_DMA(0, 0);
    __syncthreads();
    f32x16 O[4];
#pragma unroll
    for (int i = 0; i < 4; ++i)
#pragma unroll
        for (int r = 0; r < 16; ++r) O[i][r] = 0.f;
    f32x16 negm;
#pragma unroll
    for (int r = 0; r < 16; ++r) negm[r] = 0.f;
    float m = 0.f, lsum = 0.f;
    bf16x8 pf[4];
#pragma unroll
    for (int i = 0; i < 4; ++i) pf[i] = (bf16x8){0, 0, 0, 0, 0, 0, 0, 0};
#define ATT_VLD(dst, stg, db) do { _Pragma("unroll") for (int i_ = 0; i_ < 4; ++i_) dst[i_] = *(const LAS bf16x8*)((stg) + vro + (db) * 4096 + xo[i_]); } while (0)
#define ATT_PVM(src, db) do { __builtin_amdgcn_s_setprio(1); _Pragma("unroll") for (int i_ = 0; i_ < 4; ++i_) O[db] = __builtin_amdgcn_mfma_f32_32x32x16_bf16(src[i_], pf[i_], O[db], 0, 0, 0); __builtin_amdgcn_s_setprio(0); } while (0)
#define SCHEDB() __builtin_amdgcn_sched_barrier(0)
    int so_prev = 65536, so_cur = 0, so_next = 32768;
    bf16x8 va[4], vb[4];
    for (int t = 0; t < NT; ++t) {
        LAS unsigned char* cur = lds + so_cur;
        if (t + 1 < NT) ATT_DMA(so_next, t + 1);
        bf16x8 kf[8];
        if (c == 1 && t > 0) { LAS unsigned char* prv = lds + so_prev;
            ATT_VLD(va, prv, 0); SCHEDB(); ATT_VLD(vb, prv, 1); SCHEDB();
            ATT_PVM(va, 0); SCHEDB(); ATT_VLD(va, prv, 2); SCHEDB();
            ATT_PVM(vb, 1); SCHEDB(); ATT_VLD(vb, prv, 3); SCHEDB();
            ATT_PVM(va, 2); SCHEDB();
#pragma unroll
            for (int d0 = 0; d0 < 4; ++d0) { kf[2 * d0] = *(const LAS bf16x8*)(cur + kro + xo[d0]); kf[2 * d0 + 1] = *(const LAS bf16x8*)(cur + kro + 4096 + xo[d0]); }
            SCHEDB(); ATT_PVM(vb, 3); SCHEDB();
        } else {
#pragma unroll
            for (int d0 = 0; d0 < 4; ++d0) { kf[2 * d0] = *(const LAS bf16x8*)(cur + kro + xo[d0]); kf[2 * d0 + 1] = *(const LAS bf16x8*)(cur + kro + 4096 + xo[d0]); }
            SCHEDB();
        }
        f32x16 S0, S1;
        __builtin_amdgcn_s_setprio(1);
        S0 = __builtin_amdgcn_mfma_f32_32x32x16_bf16(kf[0], qr[0], negm, 0, 0, 0);
        S1 = __builtin_amdgcn_mfma_f32_32x32x16_bf16(kf[1], qr[0], negm, 0, 0, 0);
#pragma unroll
        for (int d0 = 1; d0 < 4; ++d0) {
            S0 = __builtin_amdgcn_mfma_f32_32x32x16_bf16(kf[2 * d0], qr[d0], S0, 0, 0, 0);
            S1 = __builtin_amdgcn_mfma_f32_32x32x16_bf16(kf[2 * d0 + 1], qr[d0], S1, 0, 0, 0);
        }
        __builtin_amdgcn_s_setprio(0);
        SCHEDB();
        if (c == 0) { ATT_VLD(va, cur, 0); SCHEDB(); }
        float mx = fmaxf(S0[0], S1[0]);
#pragma unroll
        for (int r = 1; r < 16; ++r) mx = fmaxf(mx, fmaxf(S0[r], S1[r]));
        mx = fmaxf(mx, __shfl_xor(mx, 32));
        if (__any(mx > 8.0f)) {
            const float dl = fmaxf(mx, 0.f), al = __builtin_amdgcn_exp2f(-dl); m += dl; lsum *= al;
#pragma unroll
            for (int r = 0; r < 16; ++r) { S0[r] -= dl; S1[r] -= dl; negm[r] = -m; }
#pragma unroll
            for (int i = 0; i < 4; ++i)
#pragma unroll
                for (int r = 0; r < 16; ++r) O[i][r] *= al;
        }
        float ps = 0.f;
#pragma unroll
        for (int r = 0; r < 16; ++r) { S0[r] = __builtin_amdgcn_exp2f(S0[r]); S1[r] = __builtin_amdgcn_exp2f(S1[r]); ps += S0[r] + S1[r]; }
        lsum += ps;
        { u32x4 w;
          w.x = cvtpk(S0[0], S0[1]); w.y = cvtpk(S0[2], S0[3]); w.z = cvtpk(S0[4], S0[5]); w.w = cvtpk(S0[6], S0[7]); pf[0] = __builtin_bit_cast(bf16x8, w);
          w.x = cvtpk(S0[8], S0[9]); w.y = cvtpk(S0[10], S0[11]); w.z = cvtpk(S0[12], S0[13]); w.w = cvtpk(S0[14], S0[15]); pf[1] = __builtin_bit_cast(bf16x8, w);
          w.x = cvtpk(S1[0], S1[1]); w.y = cvtpk(S1[2], S1[3]); w.z = cvtpk(S1[4], S1[5]); w.w = cvtpk(S1[6], S1[7]); pf[2] = __builtin_bit_cast(bf16x8, w);
          w.x = cvtpk(S1[8], S1[9]); w.y = cvtpk(S1[10], S1[11]); w.z = cvtpk(S1[12], S1[13]); w.w = cvtpk(S1[14], S1[15]); pf[3] = __builtin_bit_cast(bf16x8, w); }
        if (c == 0) { SCHEDB(); ATT_VLD(vb, cur, 1); SCHEDB(); ATT_PVM(va, 0); SCHEDB(); ATT_VLD(va, cur, 2); SCHEDB(); ATT_PVM(vb, 1); SCHEDB(); ATT_VLD(vb, cur, 3); SCHEDB(); ATT_PVM(va, 2); SCHEDB(); ATT_PVM(vb, 3); SCHEDB(); }
        __syncthreads();
        { const int tmp = so_prev; so_prev = so_cur; so_cur = so_next; so_next = tmp; }
    }
    if (c == 1) { LAS unsigned char* prv = lds + so_prev; ATT_VLD(va, prv, 0); ATT_VLD(vb, prv, 1); ATT_PVM(va, 0); ATT_VLD(va, prv, 2); ATT_PVM(vb, 1); ATT_VLD(vb, prv, 3); ATT_PVM(va, 2); ATT_PVM(vb, 3); }
#undef ATT_VLD
#undef ATT_DMA
#undef ATT_PVM
#undef SCHEDB
    __syncthreads();
    lsum += __shfl_xor(lsum, 32);
    const float il = 1.0f / lsum;
    LAS float* xb = (LAS float*)(lds + 65536) + qs * 4096;
    if (c == 1) {
#pragma unroll
        for (int db = 0; db < 4; ++db)
#pragma unroll
            for (int r = 0; r < 16; ++r) xb[(db * 16 + r) * 64 + lane] = O[db][r] * il;
    }
    __syncthreads();
    if (c == 0) {
        float ss = 0.f;
#pragma unroll
        for (int db = 0; db < 4; ++db)
#pragma unroll
            for (int r = 0; r < 16; ++r) { const float o = O[db][r] * il - lam * xb[(db * 16 + r) * 64 + lane]; O[db][r] = o; ss += o * o; }
        ss += __shfl_xor(ss, 32);
        const float rs = onorm / sqrtf(ss * (1.0f / 128.0f) + EPS);
        const int tok = q0 + qs * 32 + r32;
        const bf16_t* zr = za + (size_t)tok * INC; bf16_t* yo = Yo + (size_t)tok * D;
#pragma unroll
        for (int db = 0; db < 4; ++db)
#pragma unroll
            for (int g = 0; g < 4; ++g) { const int d = 32 * db + 8 * g + 4 * hi;
                const f32x4 gs = *(const f32x4*)(gsub + d); const u32x2 z = *(const u32x2*)(zr + d);
                const float o0 = O[db][4 * g] * rs * gs.x * bf2f(z.x & 0xffffu), o1 = O[db][4 * g + 1] * rs * gs.y * bf2f(z.x >> 16);
                const float o2 = O[db][4 * g + 2] * rs * gs.z * bf2f(z.y & 0xffffu), o3 = O[db][4 * g + 3] * rs * gs.w * bf2f(z.y >> 16);
                u32x2 w; w.x = cvtpk(o0, o1); w.y = cvtpk(o2, o3); *(u32x2*)(yo + d) = w; }
    }
    __syncthreads();
}
__device__ __forceinline__ void phase_attn(const Args& a, int l, LAS unsigned char* lds) {
    const int G = gridDim.x;
    const bf16_t* P = (const bf16_t*)(a.ws + WS_P); bf16_t* Y = (bf16_t*)(a.ws + WS_Y);
    const bf16_t* QN = (const bf16_t*)(a.ws + WS_QN); const bf16_t* KC = (const bf16_t*)(a.ws + WS_KC); const bf16_t* VT = (const bf16_t*)(a.ws + WS_VT);
    const float lam = ((const float*)(a.ws + WS_MOD))[4 * 5 * 6144 + l];
    const float lam_init = 0.8f - 0.6f * expf(-0.3f * (float)l);
    const float* gsub = a.in[15] + l * 128;
    for (int L = blockIdx.x; L < 1280; L += G) {
        if (L < 1024) { const int b = L >> 8, h = L & 7, qb = (L >> 3) & 31;
            const size_t qoff = (size_t)PB * 16 * PSEQ * 64 + (size_t)(b * 8 + h) * 2 * SSEQ * 64;
            const size_t koff = (size_t)PB * 16 * PSEQ * 64 + (size_t)(b * 8 + h) * 2 * SNK * 64;
            const size_t voff = (size_t)PB * 8 * 128 * PSEQ + (size_t)(b * 8 + h) * 128 * SNK;
            const size_t tok0 = (size_t)NPROMPT + (size_t)b * SSEQ;
            attn_item(lds, QN + qoff, SSEQ, KC + koff, VT + voff, SNK, qb * 128, lam, 1.0f - lam_init, gsub + 0, P + tok0 * INC + C_ZA + h * 128, Y + tok0 * D + 1024 + h * 128);
        } else { const int M_ = L - 1024, b = M_ >> 4, h = (M_ >> 1) & 7, qb = M_ & 1;
            const size_t qoff = (size_t)(b * 8 + h) * 2 * PSEQ * 64, voff = (size_t)(b * 8 + h) * 128 * PSEQ;
            const size_t tok0 = (size_t)b * PSEQ;
            attn_item(lds, QN + qoff, PSEQ, KC + qoff, VT + voff, PSEQ, qb * 128, lam, 1.0f - lam_init, gsub + 0, P + tok0 * INC + C_ZA + h * 128, Y + tok0 * D + 1024 + h * 128);
        }
    }
}

#define XB_TMO      128
#define XB_XCNT(j)  (256  + 64 * (j))
#define XB_XSUB(j)  (1280 + 64 * (j))
#define XB_XGEN(j)  (2304 + 64 * (j))
#define XB_TOP      3328
#define XB_TOPGEN   3392
#define XCD_BAR_WORDS 3456
#define XB_SPIN_CAP (1u << 20)
__device__ __forceinline__ unsigned xb_ld(unsigned* p)              { return __hip_atomic_load(p, __ATOMIC_RELAXED, __HIP_MEMORY_SCOPE_AGENT); }
__device__ __forceinline__ unsigned xb_add(unsigned* p, unsigned v) { return __hip_atomic_fetch_add(p, v, __ATOMIC_RELAXED, __HIP_MEMORY_SCOPE_AGENT); }
__device__ __forceinline__ unsigned xb_xcc_id() { return (unsigned)__builtin_amdgcn_s_getreg((3 << 11) | 20) & 0xFu; }
#define XB_SPIN(cond, bar) do { unsigned _sp = 0; while (cond) { __builtin_amdgcn_s_sleep(1); \
    if ((++_sp & 255u) == 0u) { if (xb_ld(&(bar)[XB_TMO])) break; if (_sp > XB_SPIN_CAP) { atomicAdd(&(bar)[XB_TMO], 1u); break; } } } } while (0)
struct XcdBarrier { unsigned* bar; unsigned x; volatile LAS unsigned* st; };
__device__ __forceinline__ XcdBarrier xcd_barrier_post(unsigned* bar, volatile LAS unsigned* st) {
    XcdBarrier b; b.bar = bar; b.x = xb_xcc_id(); b.st = st;
    if (threadIdx.x == 0) (void)xb_add(&bar[XB_XCNT(b.x)], 1u);
    return b;
}
__device__ __forceinline__ void xcd_barrier_complete(unsigned* bar, unsigned x, unsigned& nloc, unsigned& nx) {
    const unsigned G = gridDim.x * gridDim.y * gridDim.z;
    unsigned sum, cnt, mine, sp = 0u;
    for (;;) {
        sum = 0u; cnt = 0u; mine = 0u;
#pragma unroll
        for (unsigned j = 0; j < 16; ++j) { const unsigned c = xb_ld(&bar[XB_XCNT(j)]); sum += c; cnt += (c > 0u) ? 1u : 0u; mine = (j == x) ? c : mine; }
        if (sum == G) break;
        __builtin_amdgcn_s_sleep(1);
        if ((++sp & 255u) == 0u) { if (xb_ld(&bar[XB_TMO])) break; if (sp > XB_SPIN_CAP) { atomicAdd(&bar[XB_TMO], 1u); break; } }
    }
    nloc = mine > 0u ? mine : 1u; nx = cnt > 0u ? cnt : 1u;
}
__device__ __forceinline__ void xcd_barrier(const XcdBarrier& b) {
    asm volatile("s_waitcnt vmcnt(0)" ::: "memory");
    __syncthreads();
    if (threadIdx.x == 0) {
        unsigned* bar = b.bar;
        __builtin_amdgcn_s_waitcnt(0);
        unsigned nloc = b.st[0], nx = b.st[1];
        if (nloc == 0u) { xcd_barrier_complete(bar, b.x, nloc, nx); b.st[0] = nloc; b.st[1] = nx; }
        const unsigned old = xb_add(&bar[XB_XSUB(b.x)], 1u);
        const unsigned gen = old / nloc;
        if (old + 1u == (gen + 1u) * nloc) {
            __builtin_amdgcn_fence(__ATOMIC_RELEASE, "agent");
            asm volatile("s_waitcnt vmcnt(0)" ::: "memory");
            const unsigned og = xb_add(&bar[XB_TOP], 1u);
            const unsigned tg = og / nx;
            if (og + 1u == (tg + 1u) * nx) xb_add(&bar[XB_TOPGEN], 1u);
            else XB_SPIN(xb_ld(&bar[XB_TOPGEN]) == tg, bar);
            __builtin_amdgcn_fence(__ATOMIC_ACQUIRE, "agent");
            xb_add(&bar[XB_XGEN(b.x)], 1u);
            asm volatile("s_waitcnt vmcnt(0)" ::: "memory");
        } else {
            XB_SPIN(xb_ld(&bar[XB_XGEN(b.x)]) == gen, bar);
            __builtin_amdgcn_fence(__ATOMIC_ACQUIRE, "agent");
            asm volatile("s_waitcnt vmcnt(0)" ::: "memory");
        }
    }
    __syncthreads();
}

#ifndef PHMASK
#define PHMASK 0xFFFF
#endif
#define REP_IN 1
#define REP_ATTN 1
#define REP_POS 1
#define REP_PREP 1
#define REP_MERGE 1
#define REP_PRE0 1
#define REP_NORM 1
#define REP_CHAN 1
__global__ void __launch_bounds__(512, 2) fwd_kernel(Args a) {
    extern __shared__ __attribute__((aligned(16))) unsigned char lds_raw[];
    LAS unsigned char* lds = (LAS unsigned char*)lds_raw;
    cg::grid_group grid = cg::this_grid();
    const int G = gridDim.x, c = blockIdx.x;
    unsigned char* ws = a.ws;
    int ph = 0;
    volatile LAS unsigned* bst = (volatile LAS unsigned*)(lds + 131072 + 512);
    if (threadIdx.x < 2) bst[threadIdx.x] = 0u;
    __syncthreads();
    const XcdBarrier xbar = xcd_barrier_post((unsigned*)(ws + WS_CTL), bst);
#define SEAM() do { if (a.ph_lo <= ph && ph + 1 < a.ph_hi) { if (ph == 0) grid.sync(); else xcd_barrier(xbar); } ++ph; } while (0)
#define IN_PH() (a.ph_lo <= ph && ph < a.ph_hi)
    if (IN_PH()) { if constexpr (PHMASK & 1) for (int rep = 0; rep < REP_PRE0; ++rep) { phase_pre0(a, lds); __syncthreads(); } }
    SEAM();
    if (IN_PH()) { if constexpr (PHMASK & 2) phase_pre1(a); }
    SEAM();
#pragma unroll 1
    for (int l = 0; l < DEPTH; ++l) {
        if (IN_PH()) { if constexpr (PHMASK & 4) for (int rep = 0; rep < REP_NORM; ++rep) phase_norm(a, l); }
        SEAM();
        const char* Hb = (const char*)(ws + WS_H); const char* WIl = (const char*)(ws + WS_WIN) + (size_t)l * INC * D * 2; const size_t trs_ = (size_t)256 * D * 2;
        const EpiIn EI{(bf16_t*)(ws + WS_P), (bf16_t*)(ws + WS_QN), (bf16_t*)(ws + WS_KC), a.out + (size_t)41943040, a.in[13] + l * 64, a.in[14] + l * 64, (const float*)(ws + WS_TAB + 512 * 1024), l, ws + WS_GN, ws + WS_ZN};
        const pg8::Gemm gI{D, D, D};
        if (IN_PH()) if constexpr (PHMASK & 8) {
            { pg8::Order<pg8::MapGrid> S{80 * 32, G, c, pg8::MapGrid{Hb, WIl, 80, 32, trs_, trs_, 0, 0}};
              for (int rep = 0; rep < REP_IN; ++rep) pg8::gemm_phase(lds, gI, S, EI); }
            { pg8::Order<pg8::MapGrid> S{64 * 8, G, c, pg8::MapGrid{Hb, WIl, 64, 8, trs_, trs_, 0, 32}};
              pg8::gemm_phase(lds, gI, S, EI); }
        }
        SEAM();
        if (IN_PH()) if constexpr (PHMASK & 16) {
            if (c < (G >> 1)) { pg8::Order<pg8::MapGrid> S{16 * 8, G >> 1, c, pg8::MapGrid{Hb, WIl, 16, 8, trs_, trs_, 64, 32}}; pg8::gemm_phase(lds, gI, S, EI); }
            else { pg8::Gemm g{256, INC, 256};
                pg8::Order<MapChan> S{640, G - (G >> 1), c - (G >> 1), MapChan{(const char*)(ws + WS_TAB + 256 * 1024), (const char*)(ws + WS_P)}};
                EpiStore E{(bf16_t*)(ws + WS_ABT)};
                for (int rep = 0; rep < REP_CHAN; ++rep) pg8::gemm_phase(lds, g, S, E); }
        }
        SEAM();
        if (IN_PH()) {
            if constexpr (PHMASK & 32) for (int rep = 0; rep < REP_PREP; ++rep) phase_prep(a, l, lds);
            phase_fold(a);
        }
        SEAM();
        if (IN_PH()) if constexpr (PHMASK & 64) {
            { pg8::Gemm g{4096, 4096, 4096};
              pg8::Order<MapPosS> S{256, G, c, MapPosS{(const char*)(ws + WS_T4096), (const char*)(ws + WS_T4096 + 32 * MiB)}};
              EpiPos E{ws + WS_ZN, (bf16_t*)(ws + WS_Y)};
              for (int rep = 0; rep < REP_POS; ++rep) pg8::gemm_phase(lds, g, S, E); }
            { pg8::Gemm g{512, 512, 512};
              pg8::Order<MapPosP> S{64, G, c, MapPosP{(const char*)(ws + WS_TAB), (const char*)(ws + WS_ABT)}};
              EpiPos E{ws + WS_ZN, (bf16_t*)(ws + WS_Y)};
              pg8::gemm_phase(lds, g, S, E); }
            if constexpr (PHMASK & 128) for (int rep = 0; rep < REP_ATTN; ++rep) phase_attn(a, l, lds);
        }
        SEAM();
        const char* Yb = (const char*)(ws + WS_Y); const char* MGb = (const char*)(ws + WS_H);
        const char* WMl = (const char*)(ws + WS_WM) + (size_t)l * D * D * 2; const char* WOl = (const char*)(ws + WS_WO) + (size_t)l * D * D * 2;
        const size_t trs = (size_t)256 * D * 2;
        const EpiMerge EM{ws + WS_GN, (bf16_t*)(ws + WS_H)};
        const EpiOut EO{(l == 0) ? a.in[0] : a.out, (l == 0) ? a.in[1] : a.out + (size_t)NPROMPT * D, a.out, (const float*)(ws + WS_MOD) + (size_t)l * 5 * 6144};
        const pg8::Gemm gD{D, D, D};
        if (IN_PH()) if constexpr (PHMASK & 256) {
            pg8::Order<pg8::MapGrid> S{64 * 8, G, c, pg8::MapGrid{Yb, WMl, 64, 8, trs, trs, 0, 0}};
            for (int rep = 0; rep < REP_MERGE; ++rep) pg8::gemm_phase(lds, gD, S, EM);
        }
        SEAM();
        if (IN_PH()) if constexpr (PHMASK & 512) {
            if (c < (G >> 1)) { pg8::Order<pg8::MapGrid> S{16 * 8, G >> 1, c, pg8::MapGrid{Yb, WMl, 16, 8, trs, trs, 64, 0}}; pg8::gemm_phase(lds, gD, S, EM); }
            else { pg8::Order<pg8::MapGrid> S{16 * 8, G - (G >> 1), c - (G >> 1), pg8::MapGrid{MGb, WOl, 16, 8, trs, trs, 0, 0}}; pg8::gemm_phase(lds, gD, S, EO); }
        }
        SEAM();
        if (IN_PH()) if constexpr (PHMASK & 512) {
            pg8::Order<pg8::MapGrid> S{64 * 8, G, c, pg8::MapGrid{MGb, WOl, 64, 8, trs, trs, 16, 0}};
            pg8::gemm_phase(lds, gD, S, EO);
        }
        SEAM();
    }
#undef SEAM
#undef IN_PH
}
constexpr int N_PHASES = 2 + 8 * DEPTH;

extern "C" void kernel_launch(void* const* d_in, const int* in_sizes, int n_in, void* d_out, int out_size, void* d_ws, size_t ws_size, hipStream_t stream) {
    static int grid = 0;
    if (grid == 0) {
        if (n_in != 20 || ws_size < WS_END) { fprintf(stderr, "kernel_launch: unexpected n_in %d or ws_size %zu (< %zu)\n", n_in, ws_size, (size_t)WS_END); grid = -1; return; }
        int dev = 0, cus = 0, per_cu = 0;
        hipGetDevice(&dev); hipDeviceGetAttribute(&cus, hipDeviceAttributeMultiprocessorCount, dev);
        if (hipFuncSetAttribute((const void*)fwd_kernel, hipFuncAttributeMaxDynamicSharedMemorySize, LDS_BYTES) != hipSuccess) { fprintf(stderr, "kernel_launch: hipFuncSetAttribute failed\n"); grid = -1; return; }
        hipOccupancyMaxActiveBlocksPerMultiprocessor(&per_cu, (const void*)fwd_kernel, 512, LDS_BYTES);
        (void)hipGetLastError();
        if (per_cu < 1) { fprintf(stderr, "kernel_launch: occupancy query says %d blocks per CU\n", per_cu); per_cu = 1; }
        grid = cus * 1;
    }
    if (grid < 0) return;
    if (hipMemsetAsync((char*)d_ws + WS_CTL, 0, XCD_BAR_WORDS * 4, stream) != hipSuccess) { fprintf(stderr, "kernel_launch: hipMemsetAsync failed\n"); return; }
    Args a{};
    for (int i = 0; i < 20; ++i) a.in[i] = (const float*)d_in[i];
    a.out = (float*)d_out; a.ws = (unsigned char*)d_ws; a.ph_lo = 0; a.ph_hi = N_PHASES;
    void* params[] = {&a};
    hipError_t e = hipLaunchCooperativeKernel((const void*)fwd_kernel, dim3(grid), dim3(512), params, LDS_BYTES, stream);
    if (e != hipSuccess) fprintf(stderr, "cooperative launch failed: %s (grid %d)\n", hipGetErrorString(e), grid);
}
```

```cpp
#include <hip/hip_runtime.h>
#include <hip/hip_cooperative_groups.h>
#include <cstdio>
#include <cstdint>
namespace cg = cooperative_groups;

#define LAS __attribute__((address_space(3)))
typedef unsigned short bf16_t;
typedef short bf16x8 __attribute__((ext_vector_type(8)));
typedef float f32x2 __attribute__((ext_vector_type(2)));
typedef float f32x4 __attribute__((ext_vector_type(4)));
typedef float f32x16 __attribute__((ext_vector_type(16)));
typedef unsigned u32x2 __attribute__((ext_vector_type(2)));
typedef unsigned u32x4 __attribute__((ext_vector_type(4)));
typedef __bf16 bf16x2_t __attribute__((ext_vector_type(2)));

constexpr int D = 2048, DEPTH = 4, NTOK = 20480, NPROMPT = 4096, INC = 10240;
constexpr int PB = 16, PSEQ = 256, SB = 4, SSEQ = 4096, PAST = 512, SNK = PAST + SSEQ;
constexpr int C_UF = 0, C_ZF = 1024, C_Q = 2048, C_K = 3072, C_V = 4096, C_ZA = 5120, C_GF = 6144, C_GA = 8192;
constexpr float EPS = 1e-6f;
constexpr float LOG2E = 1.4426950408889634f;
constexpr float QSCALE = 0.125f * LOG2E;

constexpr size_t MiB = 1u << 20;
constexpr size_t WS_CTL = 0;
constexpr size_t WS_WIN = 1 * MiB;
constexpr size_t WS_WM = WS_WIN + 160 * MiB;
constexpr size_t WS_WO = WS_WM + 32 * MiB;
constexpr size_t WS_MODP = WS_WO + 32 * MiB;
constexpr size_t WS_MOD = WS_MODP + 8 * MiB;
constexpr size_t WS_TAB = WS_MOD + 1 * MiB;
constexpr size_t WS_T4096 = WS_TAB + 1 * MiB;
constexpr size_t WS_H = WS_T4096 + 64 * MiB;
constexpr size_t WS_P = WS_H + 80 * MiB;
constexpr size_t WS_ABT = WS_P + 400 * MiB;
constexpr size_t WS_Y = WS_ABT + 80 * MiB;
constexpr size_t WS_QN = WS_Y + 80 * MiB;
constexpr size_t WS_KC = WS_QN + 40 * MiB;
constexpr size_t WS_VT = WS_KC + 44 * MiB;
constexpr size_t WS_GN = WS_VT + 44 * MiB;
constexpr size_t WS_ZN = WS_GN + 160 * MiB;
constexpr size_t WS_END = WS_ZN + 40 * MiB;
__device__ __forceinline__ size_t nat_off(int tile, int ai, int m, int bj, int wave, int lane) { return ((((size_t)tile * 8 + ai * 4 + m) * 2 + bj) * 8 + wave) * 1024 + (size_t)lane * 16; }
constexpr int LDS_BYTES = 147456;

__device__ __forceinline__ float bf2f(unsigned b) { return __uint_as_float(b << 16); }
__device__ __forceinline__ unsigned cvtpk(float lo, float hi) { f32x2 v = {lo, hi}; bf16x2_t b = __builtin_convertvector(v, bf16x2_t); return __builtin_bit_cast(unsigned, b); }
__device__ __forceinline__ float sigmoidf_(float x) { return __builtin_amdgcn_rcpf(1.0f + __builtin_amdgcn_exp2f(-x * LOG2E)); }
__device__ __forceinline__ float siluf_(float x) { return x * sigmoidf_(x); }
__device__ __forceinline__ float wave_sum(float v) {
#pragma unroll
    for (int o = 1; o < 64; o <<= 1) v += __shfl_xor(v, o);
    return v;
}
__device__ __forceinline__ void unpack8(const u32x4 w, float* f) {
    f[0] = bf2f(w.x & 0xffffu); f[1] = bf2f(w.x >> 16); f[2] = bf2f(w.y & 0xffffu); f[3] = bf2f(w.y >> 16);
    f[4] = bf2f(w.z & 0xffffu); f[5] = bf2f(w.z >> 16); f[6] = bf2f(w.w & 0xffffu); f[7] = bf2f(w.w >> 16);
}

namespace pg8 {
constexpr int BM = 256, BK = 64, HALF = 128, HTB = HALF * BK * 2, STAGE_BYTES = 8 * HTB, NXCD = 8, WGM = 8;
__host__ __device__ __forceinline__ int lds_byte(int r, int c) { const int st = (r >> 4) * 2 + (c >> 5), rr = r & 15, cc = c & 31, ob = rr * 64 + cc * 2; return st * 1024 + (ob ^ (((ob >> 9) & 1) << 5)); }
__host__ __device__ __forceinline__ void stage_rc(int b, int& R, int& C) { const int st = b / 1024, sb = b % 1024, swz = sb ^ (((sb >> 9) & 1) << 5); R = (st >> 1) * 16 + swz / 64; C = (st & 1) * 32 + (swz % 64) / 2; }
__host__ __device__ __forceinline__ int perm32(int rho) { const int n = rho >> 4, i = rho & 15; return 8 * (i >> 2) + 4 * n + (i & 3); }

struct Unit { const char* aP; const char* bP; size_t co; int ldc; int r0, c0; };
struct Gemm { int lda, ldb, K; };

template <class Map> struct Order {
    int n, G, c; Map map;
    __device__ __forceinline__ bool next(int i, Unit& u) const { const long L = (long)i * G + c; if (L >= n) return false; map((int)L, u); return true; }
};
struct MapGrid {
    const char* A; const char* B; int nM, nN; size_t ars, brs; int pm0, pn0;
    __device__ __forceinline__ void operator()(int L, Unit& u) const {
        const int nwg = nM * nN; int wgid = L;
        { const int q = nwg / NXCD, r = nwg % NXCD, xcd = wgid % NXCD, off = wgid / NXCD; wgid = (xcd < r ? xcd * (q + 1) : r * (q + 1) + (xcd - r) * q) + off; }
        const int nig = WGM * nN, gid = wgid / nig, fm = gid * WGM, gsz = (nM - fm) < WGM ? (nM - fm) : WGM;
        const int pm = pm0 + fm + ((wgid % nig) % gsz), pn = pn0 + (wgid % nig) / gsz;
        u.aP = A + (size_t)pm * ars; u.bP = B + (size_t)pn * brs; u.r0 = pm * BM; u.c0 = pn * BM; u.co = 0; u.ldc = 0;
    }
};

template <class Epi, class Sched>
__device__ __forceinline__ void gemm_phase(LAS unsigned char* lds, const Gemm g, const Sched& S, const Epi& E) {
    int tid_ = threadIdx.x; asm volatile("" : "+v"(tid_));
    const int tid = tid_, wid = __builtin_amdgcn_readfirstlane(tid >> 6), lane = tid & 63, wr = wid >> 2, wc = wid & 3, fr = lane & 15, fq = lane >> 4;
    const int K = g.K, nt = K / BK;
    unsigned voffA[2], voffB[2];
#pragma unroll
    for (int i = 0; i < 2; ++i) { int R, C; stage_rc(tid * 16 + i * 8192, R, C); const int Rb = Epi::CH64 ? (64 * (R >> 5) + perm32(R & 31)) : Epi::PERM ? ((R & ~31) + perm32(R & 31)) : R;
        voffA[i] = (unsigned)(R * g.lda + C) * 2u; voffB[i] = (unsigned)(Rb * g.ldb + C) * 2u; }
    const size_t kstep = (size_t)(BK * 2);
    const size_t hstepA = (size_t)HALF * g.lda * 2, hstepB = (size_t)(Epi::CH64 ? 32 : HALF) * g.ldb * 2;
    const unsigned ldsw = (unsigned)wid * 1024u;
    const int aoff = lds_byte(wr * 64 + fr, fq * 8), boff = lds_byte(wc * 32 + fr, fq * 8);
#define PG8_SA(b, h) (((b) * 2 + (h)) * HTB)
#define PG8_SB(b, h) ((4 + (b) * 2 + (h)) * HTB)
#define PG8_STAGE(bufoff, gbase, voff) do { const char* _gb = (const char*)(gbase); asm volatile("" : "+s"(_gb)); _Pragma("unroll") for (int _i = 0; _i < 2; ++_i) \
        __builtin_amdgcn_global_load_lds((const unsigned*)(_gb + (voff)[_i]), (LAS unsigned*)(lds + (bufoff) + ldsw + _i * 8192), 16, 0, 0); } while (0)
#define PG8_LDA(dst, b, h) do { _Pragma("unroll") for (int m = 0; m < 4; ++m) _Pragma("unroll") for (int k = 0; k < 2; ++k) dst[m][k] = *(const LAS bf16x8*)(lds + PG8_SA(b, h) + aoff + m * 2048 + k * 1024); } while (0)
#define PG8_LDB(dst, b, h) do { _Pragma("unroll") for (int n = 0; n < 2; ++n) _Pragma("unroll") for (int k = 0; k < 2; ++k) dst[n][k] = *(const LAS bf16x8*)(lds + PG8_SB(b, h) + boff + n * 2048 + k * 1024); } while (0)
#define PG8_MMA(ai, bj, At, Bt) do { __builtin_amdgcn_s_setprio(1); _Pragma("unroll") for (int m = 0; m < 4; ++m) _Pragma("unroll") for (int n = 0; n < 2; ++n) _Pragma("unroll") for (int k = 0; k < 2; ++k) \
        acc[ai][bj][m][n] = __builtin_amdgcn_mfma_f32_16x16x32_bf16(Bt[n][k], At[m][k], acc[ai][bj][m][n], 0, 0, 0); __builtin_amdgcn_s_setprio(0); } while (0)
#define PG8_WAIT_V(n) asm volatile("s_waitcnt vmcnt(" #n ")" ::: "memory")
#define PG8_WAIT_L(n) asm volatile("s_waitcnt lgkmcnt(" #n ")" ::: "memory")
#define PG8_BAR __builtin_amdgcn_s_barrier()
#define PG8_SCHED __builtin_amdgcn_sched_barrier(0)
    Unit cur, nxt; int ui = 0;
    if (!S.next(0, cur)) return;
    f32x4 acc[2][2][4][2];
#pragma unroll
    for (int a = 0; a < 2; ++a)
#pragma unroll
        for (int b = 0; b < 2; ++b)
#pragma unroll
            for (int m = 0; m < 4; ++m)
#pragma unroll
                for (int n = 0; n < 2; ++n) acc[a][b][m][n] = (f32x4){0.f, 0.f, 0.f, 0.f};
    bf16x8 At[4][2], B0[2][2], B1[2][2];
    const char* cA = cur.aP; const char* cB = cur.bP;
    PG8_STAGE(PG8_SB(0, 0), cB, voffB); PG8_STAGE(PG8_SB(0, 1), cB + hstepB, voffB); PG8_STAGE(PG8_SA(0, 0), cA, voffA); PG8_STAGE(PG8_SA(0, 1), cA + hstepA, voffA);
    if (wr == 1) PG8_BAR;
    PG8_WAIT_V(2); PG8_BAR;
    PG8_STAGE(PG8_SB(1, 0), cB + kstep, voffB); PG8_STAGE(PG8_SA(1, 0), cA + kstep, voffA); PG8_STAGE(PG8_SB(1, 1), cB + hstepB + kstep, voffB);
    PG8_WAIT_V(6); PG8_BAR;
    for (;;) {
        const bool has_next = S.next(ui + 1, nxt);
        const char* nA = has_next ? nxt.aP : cA; const char* nB = has_next ? nxt.bP : cB;
#pragma unroll 1
        for (int t = 0; t < nt; t += 2) {
            const bool last = (t == nt - 2);
            const char* a1 = cA + (size_t)(t + 1) * kstep;
            const char* a2 = last ? nA : cA + (size_t)(t + 2) * kstep; const char* b2 = last ? nB : cB + (size_t)(t + 2) * kstep;
            const char* a3 = a2 + kstep; const char* b3 = b2 + kstep;
            if constexpr (Epi::HAS_MID) { if (t == (nt >> 1)) E.mid(acc, cur, wr, wc, fr, fq); }
            PG8_LDB(B0, 0, 0); PG8_LDB(B1, 0, 1); PG8_SCHED; PG8_LDA(At, 0, 0); PG8_STAGE(PG8_SA(1, 1), a1 + hstepA, voffA);
            PG8_WAIT_V(8); PG8_WAIT_L(0); PG8_BAR; PG8_MMA(0, 0, At, B0); PG8_MMA(0, 1, At, B1); PG8_BAR; PG8_SCHED;
            PG8_LDA(At, 0, 1); PG8_STAGE(PG8_SB(0, 0), b2, voffB); PG8_STAGE(PG8_SB(0, 1), b2 + hstepB, voffB); PG8_STAGE(PG8_SA(0, 0), a2, voffA);
            PG8_WAIT_V(8); PG8_WAIT_L(0); PG8_BAR; PG8_MMA(1, 0, At, B0); PG8_MMA(1, 1, At, B1); PG8_BAR; PG8_SCHED;
            PG8_LDB(B0, 1, 0); PG8_LDB(B1, 1, 1); PG8_SCHED; PG8_LDA(At, 1, 0); PG8_STAGE(PG8_SA(0, 1), a2 + hstepA, voffA);
            PG8_WAIT_V(8); PG8_WAIT_L(0); PG8_BAR; PG8_MMA(0, 0, At, B0); PG8_MMA(0, 1, At, B1); PG8_BAR; PG8_SCHED;
            PG8_LDA(At, 1, 1); PG8_STAGE(PG8_SB(1, 0), b3, voffB); PG8_STAGE(PG8_SB(1, 1), b3 + hstepB, voffB); PG8_STAGE(PG8_SA(1, 0), a3, voffA);
            PG8_WAIT_V(8); PG8_WAIT_L(0); PG8_BAR; PG8_MMA(1, 0, At, B0); PG8_MMA(1, 1, At, B1); PG8_BAR; PG8_SCHED;
        }
        if (wr == 0) PG8_BAR;
        E(acc, cur, wr, wc, fr, fq);
        if constexpr (Epi::PROBE2) E(acc, cur, wr, wc, fr, fq);
        if (!has_next) break;
#pragma unroll
        for (int a = 0; a < 2; ++a)
#pragma unroll
            for (int b = 0; b < 2; ++b)
#pragma unroll
                for (int m = 0; m < 4; ++m)
#pragma unroll
                    for (int n = 0; n < 2; ++n) acc[a][b][m][n] = (f32x4){0.f, 0.f, 0.f, 0.f};
        cur = nxt; cA = nA; cB = nB; ++ui;
        if (wr == 1) PG8_BAR;
    }
    PG8_WAIT_V(0);
    PG8_BAR;
#undef PG8_SA
#undef PG8_SB
#undef PG8_STAGE
#undef PG8_LDA
#undef PG8_LDB
#undef PG8_MMA
#undef PG8_WAIT_V
#undef PG8_WAIT_L
#undef PG8_BAR
#undef PG8_SCHED
}
}
using pg8::Unit;


struct EpiIn {
    static constexpr bool PERM = true, HAS_MID = false, PROBE2 = false, CH64 = true;
    bf16_t* P; bf16_t* QN; bf16_t* KC; float* ock; const float* gq; const float* gk; const float* RT; int l; unsigned char* GN; unsigned char* ZN;
    __device__ __forceinline__ void operator()(const f32x4 (&acc)[2][2][4][2], const Unit& u, int wr, int wc, int fr, int fq) const {
        const int pn = u.c0 >> 8;
        const int row0 = u.r0 + wr * 64 + fr;
        if (pn >= 8 && pn < 16) {
            const bool isq = pn < 12, smp = u.r0 >= NPROMPT;
            const int hc = ((u.c0 - (isq ? C_Q : C_K)) >> 6) + wc;
            const float* gp = (isq ? gq : gk) + 8 * fq;
            const f32x4 g00 = *(const f32x4*)gp, g01 = *(const f32x4*)(gp + 4), g10 = *(const f32x4*)(gp + 32), g11 = *(const f32x4*)(gp + 36);
            const bool isx2 = fq >= 2; const int jb = 8 * (fq & 1);
#pragma unroll
            for (int ai = 0; ai < 2; ++ai)
#pragma unroll
                for (int m = 0; m < 4; ++m) { int rowi = row0 + ai * 128 + m * 16; asm volatile("" : "+v"(rowi) :: "memory");
                    f32x4 y[2][2] = {{acc[ai][0][m][0], acc[ai][0][m][1]}, {acc[ai][1][m][0], acc[ai][1][m][1]}};
                    float ss = 0.f;
#pragma unroll
                    for (int a_ = 0; a_ < 2; ++a_)
#pragma unroll
                        for (int b_ = 0; b_ < 2; ++b_) ss += (y[a_][b_][0] * y[a_][b_][0] + y[a_][b_][1] * y[a_][b_][1]) + (y[a_][b_][2] * y[a_][b_][2] + y[a_][b_][3] * y[a_][b_][3]);
                    ss += __shfl_xor(ss, 16); ss += __shfl_xor(ss, 32);
                    const float rs = 1.0f / sqrtf(ss * (1.0f / 64.0f) + EPS);
                    y[0][0] = y[0][0] * rs * g00; y[0][1] = y[0][1] * rs * g01; y[1][0] = y[1][0] * rs * g10; y[1][1] = y[1][1] * rs * g11;
                    int b, n, Nq, Nk, koff; size_t base;
                    if (!smp) { b = rowi >> 8; n = rowi & 255; Nq = PSEQ; Nk = PSEQ; koff = 0; base = 0; }
                    else { const int r2 = rowi - NPROMPT; b = r2 >> 12; n = r2 & 4095; Nq = SSEQ; Nk = SNK; koff = PAST; base = (size_t)PB * 16 * PSEQ * 64; }
                    if (smp) {
                        const float* tr = RT + (n >> 6) * 16 + jb; const float* tc = RT + (n & 63) * 16 + jb;
#pragma unroll
                        for (int a_ = 0; a_ < 2; ++a_) { const float* tp = a_ ? tc : tr;
#pragma unroll
                            for (int b_ = 0; b_ < 2; ++b_) { const f32x4 c4 = *(const f32x4*)(tp + 4 * b_), s4 = *(const f32x4*)(tp + 1024 + 4 * b_);
#pragma unroll
                                for (int j = 0; j < 4; ++j) { const float pr = __shfl_xor(y[a_][b_][j], 32); y[a_][b_][j] = isx2 ? (y[a_][b_][j] * c4[j] + pr * s4[j]) : (y[a_][b_][j] * c4[j] - pr * s4[j]); } } }
                    }
                    if (isq) { bf16_t* dst = QN + base + ((size_t)(b * 16 + hc) * Nq + n) * 64 + 8 * fq;
#pragma unroll
                        for (int a_ = 0; a_ < 2; ++a_) { const f32x4 v0 = y[a_][0] * QSCALE, v1 = y[a_][1] * QSCALE;
                            u32x4 w; w.x = cvtpk(v0[0], v0[1]); w.y = cvtpk(v0[2], v0[3]); w.z = cvtpk(v1[0], v1[1]); w.w = cvtpk(v1[2], v1[3]); *(u32x4*)(dst + 32 * a_) = w; } }
                    else { bf16_t* dst = KC + base + ((size_t)(b * 16 + hc) * Nk + koff + n) * 64 + 8 * fq;
#pragma unroll
                        for (int a_ = 0; a_ < 2; ++a_) { const f32x4 v0 = y[a_][0], v1 = y[a_][1];
                            u32x4 w; w.x = cvtpk(v0[0], v0[1]); w.y = cvtpk(v0[2], v0[3]); w.z = cvtpk(v1[0], v1[1]); w.w = cvtpk(v1[2], v1[3]); *(u32x4*)(dst + 32 * a_) = w; }
                        if (!smp) { float* o = ock + ((size_t)(b * DEPTH + l) * PSEQ + n) * 1024 + hc * 64 + 8 * fq;
#pragma unroll
                            for (int a_ = 0; a_ < 2; ++a_) { *(f32x4*)(o + 32 * a_) = y[a_][0]; *(f32x4*)(o + 32 * a_ + 4) = y[a_][1]; } } }
                    asm volatile("" ::: "memory"); }
            return;
        }
        const int mode = (pn < 4) ? 0 : (pn < 8) ? 1 : (pn < 20) ? 0 : (pn < 24) ? 1 : 2;
        const int col0 = u.c0 + wc * 64 + 8 * fq;
        const bool native = (pn >= 4 && pn < 8) || pn >= 24;
        unsigned char* nbase = (pn >= 24) ? GN + nat_off((u.r0 >> 8) * 16 + (pn - 24), 0, 0, 0, wr * 4 + wc, 0) : ZN + nat_off((u.r0 >> 8) * 4 + (pn - 4), 0, 0, 0, wr * 4 + wc, 0);
#pragma unroll
        for (int ai = 0; ai < 2; ++ai)
#pragma unroll
            for (int m = 0; m < 4; ++m) { int rowi = row0 + ai * 128 + m * 16; asm volatile("" : "+v"(rowi) :: "memory"); bf16_t* rowp = P + (size_t)rowi * INC + col0;
#pragma unroll
                for (int bj = 0; bj < 2; ++bj) { f32x4 v0 = acc[ai][bj][m][0], v1 = acc[ai][bj][m][1];
                    if (mode == 1) {
#pragma unroll
                        for (int j = 0; j < 4; ++j) { v0[j] = siluf_(v0[j]); v1[j] = siluf_(v1[j]); } }
                    else if (mode == 2) {
#pragma unroll
                        for (int j = 0; j < 4; ++j) { v0[j] = sigmoidf_(v0[j]); v1[j] = sigmoidf_(v1[j]); } }
                    u32x4 w; w.x = cvtpk(v0[0], v0[1]); w.y = cvtpk(v0[2], v0[3]); w.z = cvtpk(v1[0], v1[1]); w.w = cvtpk(v1[2], v1[3]);
                    if (native) { unsigned vo = (unsigned)(fr + 16 * fq) * 16u; asm volatile("" : "+v"(vo)); __builtin_nontemporal_store(w, (u32x4*)(nbase + (size_t)((ai * 4 + m) * 2 + bj) * 8192 + vo)); } else __builtin_nontemporal_store(w, (u32x4*)(rowp + bj * 32)); }
                asm volatile("" ::: "memory"); }
    }
};
struct EpiStore {
    static constexpr bool PERM = true, HAS_MID = false, PROBE2 = false, CH64 = false;
    bf16_t* O;
    __device__ __forceinline__ void operator()(const f32x4 (&acc)[2][2][4][2], const Unit& u, int wr, int wc, int fr, int fq) const {
        bf16_t* base = O + u.co + (size_t)(wr * 64 + fr) * u.ldc + wc * 32 + 8 * fq;
#pragma unroll
        for (int ai = 0; ai < 2; ++ai)
#pragma unroll
            for (int m = 0; m < 4; ++m) { int rowi = ai * 128 + m * 16; asm volatile("" : "+v"(rowi) :: "memory"); bf16_t* rowp = base + (size_t)rowi * u.ldc;
#pragma unroll
                for (int bj = 0; bj < 2; ++bj) { const f32x4 v0 = acc[ai][bj][m][0], v1 = acc[ai][bj][m][1];
                    u32x4 w; w.x = cvtpk(v0[0], v0[1]); w.y = cvtpk(v0[2], v0[3]); w.z = cvtpk(v1[0], v1[1]); w.w = cvtpk(v1[2], v1[3]);
                    *(u32x4*)(rowp + bj * 128) = w; }
                asm volatile("" ::: "memory"); }
    }
};
struct EpiPos {
    static constexpr bool PERM = true, HAS_MID = false, PROBE2 = false, CH64 = true;
    const unsigned char* ZN; bf16_t* Y;
    __device__ __forceinline__ void operator()(const f32x4 (&acc)[2][2][4][2], const Unit& u, int wr, int wc, int fr, int fq) const {
        const int row0 = u.r0 + wr * 64 + fr, col0 = u.c0 + wc * 64 + 8 * fq;
        const unsigned char* nb = ZN + nat_off((u.r0 >> 8) * 4 + (u.c0 >> 8), 0, 0, 0, wr * 4 + wc, 0);
#pragma unroll
        for (int ai = 0; ai < 2; ++ai)
#pragma unroll
            for (int m = 0; m < 4; ++m) { int rowi = row0 + ai * 128 + m * 16; asm volatile("" : "+v"(rowi) :: "memory"); const size_t row = (size_t)rowi;
#pragma unroll
                for (int bj = 0; bj < 2; ++bj) { const f32x4 v0 = acc[ai][bj][m][0], v1 = acc[ai][bj][m][1];
                    unsigned vo = (unsigned)(fr + 16 * fq) * 16u; asm volatile("" : "+v"(vo)); const u32x4 z = *(const u32x4*)(nb + (size_t)((ai * 4 + m) * 2 + bj) * 8192 + vo); float zf[8]; unpack8(z, zf);
                    u32x4 w; w.x = cvtpk(v0[0] * zf[0], v0[1] * zf[1]); w.y = cvtpk(v0[2] * zf[2], v0[3] * zf[3]); w.z = cvtpk(v1[0] * zf[4], v1[1] * zf[5]); w.w = cvtpk(v1[2] * zf[6], v1[3] * zf[7]);
                    *(u32x4*)(Y + row * D + col0 + bj * 32) = w; }
                asm volatile("" ::: "memory"); }
    }
};
struct EpiMerge {
    static constexpr bool PERM = true, HAS_MID = true, PROBE2 = false, CH64 = true;
    const unsigned char* GN; bf16_t* MG;
    __device__ __forceinline__ void mid(f32x4 (&acc)[2][2][4][2], const Unit& u, int wr, int wc, int fr, int fq) const {
        const unsigned char* gfb = GN + nat_off((u.r0 >> 8) * 16 + (u.c0 >> 8), 0, 0, 0, wr * 4 + wc, 0); const unsigned char* gab = gfb + (size_t)8 * 131072;
#pragma unroll
        for (int ai = 0; ai < 2; ++ai) {
            unsigned vo = (unsigned)(fr + 16 * fq) * 16u; asm volatile("" : "+v"(vo) :: "memory");
            u32x4 ra[4][2], rb[4][2];
#pragma unroll
            for (int m = 0; m < 4; ++m)
#pragma unroll
                for (int bj = 0; bj < 2; ++bj) { const size_t o = (size_t)((ai * 4 + m) * 2 + bj) * 8192; ra[m][bj] = *(const u32x4*)(gfb + o + vo); rb[m][bj] = *(const u32x4*)(gab + o + vo); }
            __builtin_amdgcn_sched_barrier(0);
#pragma unroll
            for (int m = 0; m < 4; ++m)
#pragma unroll
                for (int bj = 0; bj < 2; ++bj) { float gf[8], ga[8]; unpack8(ra[m][bj], gf); unpack8(rb[m][bj], ga);
#pragma unroll
                    for (int j = 0; j < 4; ++j) { acc[ai][bj][m][0][j] *= gf[j] * __builtin_amdgcn_rcpf(ga[j]); acc[ai][bj][m][1][j] *= gf[4 + j] * __builtin_amdgcn_rcpf(ga[4 + j]); } }
            asm volatile("" ::: "memory"); }
    }
    __device__ __forceinline__ void operator()(const f32x4 (&acc)[2][2][4][2], const Unit& u, int wr, int wc, int fr, int fq) const {
        const int row0 = u.r0 + wr * 64 + fr, col0 = u.c0 + wc * 64 + 8 * fq;
        const unsigned char* gab = GN + nat_off((u.r0 >> 8) * 16 + 8 + (u.c0 >> 8), 0, 0, 0, wr * 4 + wc, 0);
#pragma unroll
        for (int ai = 0; ai < 2; ++ai)
#pragma unroll
            for (int m = 0; m < 4; ++m) { int rowi = row0 + ai * 128 + m * 16; asm volatile("" : "+v"(rowi) :: "memory"); const size_t row = (size_t)rowi;
#pragma unroll
                for (int bj = 0; bj < 2; ++bj) { const f32x4 v0 = acc[ai][bj][m][0], v1 = acc[ai][bj][m][1];
                    unsigned vo = (unsigned)(fr + 16 * fq) * 16u; asm volatile("" : "+v"(vo)); const u32x4 b = *(const u32x4*)(gab + (size_t)((ai * 4 + m) * 2 + bj) * 8192 + vo); float ga[8]; unpack8(b, ga);
                    u32x4 w; w.x = cvtpk(v0[0] * ga[0], v0[1] * ga[1]); w.y = cvtpk(v0[2] * ga[2], v0[3] * ga[3]); w.z = cvtpk(v1[0] * ga[4], v1[1] * ga[5]); w.w = cvtpk(v1[2] * ga[6], v1[3] * ga[7]);
                    *(u32x4*)(MG + row * D + col0 + bj * 32) = w; }
                asm volatile("" ::: "memory"); }
    }
};
struct EpiOut {
    static constexpr bool PERM = false, HAS_MID = false, PROBE2 = false, CH64 = false;
    const float* xp; const float* xs; float* out; const float* mod;
    __device__ __forceinline__ void operator()(const f32x4 (&acc)[2][2][4][2], const Unit& u, int wr, int wc, int fr, int fq) const {
        const int row0 = u.r0 + wr * 64 + fr, col0 = u.c0 + wc * 32 + 4 * fq;
        const int cv = (u.r0 < NPROMPT) ? 0 : 1 + ((u.r0 - NPROMPT) >> 12);
        const float* gate = mod + cv * 6144 + 4096 + col0;
        const float* xin = (u.r0 < NPROMPT) ? xp : xs - (size_t)NPROMPT * D;
        f32x4 gv[2][2];
#pragma unroll
        for (int bj = 0; bj < 2; ++bj)
#pragma unroll
            for (int n = 0; n < 2; ++n) gv[bj][n] = *(const f32x4*)(gate + bj * 128 + n * 16);
        f32x4 xn[2][2];
        { int rowi = row0; asm volatile("" : "+v"(rowi) :: "memory"); const size_t off = (size_t)rowi * D + col0;
#pragma unroll
          for (int bj = 0; bj < 2; ++bj)
#pragma unroll
              for (int n = 0; n < 2; ++n) xn[bj][n] = *(const f32x4*)(xin + off + bj * 128 + n * 16); }
#pragma unroll
        for (int g = 0; g < 8; ++g) { const int ai = g >> 2, m = g & 3;
            f32x4 xo[2][2];
#pragma unroll
            for (int bj = 0; bj < 2; ++bj)
#pragma unroll
                for (int n = 0; n < 2; ++n) xo[bj][n] = xn[bj][n];
            if (g < 7) { int rowi = row0 + ((g + 1) >> 2) * 128 + ((g + 1) & 3) * 16; asm volatile("" : "+v"(rowi)); const size_t off = (size_t)rowi * D + col0;
#pragma unroll
                for (int bj = 0; bj < 2; ++bj)
#pragma unroll
                    for (int n = 0; n < 2; ++n) xn[bj][n] = *(const f32x4*)(xin + off + bj * 128 + n * 16); }
            __builtin_amdgcn_sched_barrier(0);
            { int rowi = row0 + ai * 128 + m * 16; asm volatile("" : "+v"(rowi)); const size_t off = (size_t)rowi * D + col0;
#pragma unroll
              for (int bj = 0; bj < 2; ++bj)
#pragma unroll
                  for (int n = 0; n < 2; ++n) *(f32x4*)(out + off + bj * 128 + n * 16) = xo[bj][n] + gv[bj][n] * acc[ai][bj][m][n]; }
            __builtin_amdgcn_sched_barrier(0); }
        asm volatile("" ::: "memory");
    }
};

struct MapChan {
    const char* CST; const char* P;
    __device__ __forceinline__ void operator()(int L, Unit& u) const {
        int b, g, pm, pn, N1, tok0; size_t abt;
        if (L < 128) { b = L >> 3; g = (L >> 1) & 3; pm = L & 1; pn = 0; N1 = PSEQ; tok0 = b * PSEQ; abt = (size_t)b * 1024 * 512; }
        else { const int M_ = L - 128; b = M_ >> 7; g = (M_ >> 5) & 3; pm = (M_ >> 4) & 1; pn = M_ & 15; N1 = SSEQ; tok0 = NPROMPT + b * SSEQ; abt = (size_t)PB * 1024 * 512 + (size_t)b * 1024 * 8192; }
        u.aP = CST + (size_t)pm * 256 * 256 * 2;
        u.bP = P + ((size_t)(tok0 + pn * 256) * INC + C_UF + g * 256) * 2;
        u.co = abt + (size_t)(g * 256) * (2 * N1) + (size_t)pm * N1 + pn * 256; u.ldc = 2 * N1; u.r0 = 0; u.c0 = 0;
    }
};
struct MapPosP {
    const char* T; const char* ABT;
    __device__ __forceinline__ void operator()(int L, Unit& u) const {
        const int b = L >> 2, pn = L & 3;
        u.aP = T; u.bP = ABT + ((size_t)b * 1024 * 512 + (size_t)pn * 256 * 512) * 2; u.r0 = b * PSEQ; u.c0 = pn * 256; u.co = 0; u.ldc = 0;
    }
};
struct MapPosS {
    const char* T; const char* FB;
    __device__ __forceinline__ void operator()(int L, Unit& u) const {
        const int b = L >> 6, pm = (L >> 2) & 15, pn = L & 3;
        u.aP = T + (size_t)pm * 256 * 4096 * 2; u.bP = FB + ((size_t)b * 1024 * 4096 + (size_t)pn * 256 * 4096) * 2;
        u.r0 = NPROMPT + b * SSEQ + pm * 256; u.c0 = pn * 256; u.co = 0; u.ldc = 0;
    }
};

struct Args {
    const float* in[20]; float* out; unsigned char* ws; int ph_lo, ph_hi;
};

__device__ __forceinline__ void transpose_item(const float* W, int N, bf16_t* WT, int ldwt, int koff, LAS float* scr, int item, int lane) {
    const int nblk = N / 32, kb = item / nblk, nb = item % nblk, k0 = 64 * kb, n0 = 32 * nb;
#pragma unroll 8
    for (int i = 0; i < 32; ++i) { const int kk = 2 * i + (lane >> 5); scr[kk * 33 + (lane & 31)] = W[(size_t)(k0 + kk) * N + n0 + (lane & 31)]; }
    asm volatile("s_waitcnt lgkmcnt(0)" ::: "memory");
    const int c = lane & 7;
#pragma unroll
    for (int j = 0; j < 4; ++j) { const int n = (lane >> 3) + 8 * j; const LAS float* s = scr + (8 * c) * 33 + n;
        u32x4 o; o.x = cvtpk(s[0 * 33], s[1 * 33]); o.y = cvtpk(s[2 * 33], s[3 * 33]); o.z = cvtpk(s[4 * 33], s[5 * 33]); o.w = cvtpk(s[6 * 33], s[7 * 33]);
        *(u32x4*)(WT + (size_t)(n0 + n) * ldwt + koff + k0 + 8 * c) = o; }
    asm volatile("s_waitcnt lgkmcnt(0)" ::: "memory");
}

__device__ __forceinline__ void phase_pre0(const Args& a, LAS unsigned char* lds) {
    const int tid = threadIdx.x, lane = tid & 63, wave = __builtin_amdgcn_readfirstlane(tid >> 6), G = gridDim.x;
    unsigned char* ws = a.ws;
    {
        LAS float* scr = (LAS float*)(lds + wave * 16384);
        const int gw = blockIdx.x * 8 + wave, NGW = G * 8;
        constexpr int I_IN = 4 * 32 * 320, I_F = 4 * 16 * 64, I_O = 4 * 32 * 64, NIT = I_IN + 2 * I_F + I_O;
        bf16_t* WIN = (bf16_t*)(ws + WS_WIN); bf16_t* WM = (bf16_t*)(ws + WS_WM); bf16_t* WO = (bf16_t*)(ws + WS_WO);
        for (int it = gw; it < NIT; it += NGW) {
            int r = it;
            if (r < I_IN) { const int l = r / 10240, rr = r % 10240; transpose_item(a.in[6] + (size_t)l * D * INC, INC, WIN + (size_t)l * INC * D, D, 0, scr, rr, lane); continue; } r -= I_IN;
            if (r < I_F) { const int l = r / 1024, rr = r % 1024; transpose_item(a.in[7] + (size_t)l * 1024 * D, D, WM + (size_t)l * D * D, D, 0, scr, rr, lane); continue; } r -= I_F;
            if (r < I_F) { const int l = r / 1024, rr = r % 1024; transpose_item(a.in[8] + (size_t)l * 1024 * D, D, WM + (size_t)l * D * D, D, 1024, scr, rr, lane); continue; } r -= I_F;
            { const int l = r / 2048, rr = r % 2048; transpose_item(a.in[9] + (size_t)l * D * D, D, WO + (size_t)l * D * D, D, 0, scr, rr, lane); }
        }
    }
    __syncthreads();
    {
        LAS float* sc = (LAS float*)lds;
        float* MODP = (float*)(ws + WS_MODP);
        const float* wmod = a.in[10];
        for (int un = blockIdx.x; un < 768; un += G) {
            const int l = un / 192, part = (un / 12) % 16, jb = un % 12, j = jb * 512 + tid;
            __syncthreads();
            for (int idx = tid; idx < 640; idx += 512) { const int c = idx >> 7, i = idx & 127;
                const float v = (c == 0) ? a.in[5][part * 128 + i] : a.in[2][(c - 1) * D + part * 128 + i]; sc[idx] = siluf_(v); }
            __syncthreads();
            float s0 = 0.f, s1 = 0.f, s2 = 0.f, s3 = 0.f, s4 = 0.f;
            const float* wp = wmod + ((size_t)l * D + part * 128) * 6144 + j;
#pragma unroll 8
            for (int i = 0; i < 128; ++i) { const float w = wp[(size_t)i * 6144]; s0 += sc[i] * w; s1 += sc[128 + i] * w; s2 += sc[256 + i] * w; s3 += sc[384 + i] * w; s4 += sc[512 + i] * w; }
            float* o = MODP + ((size_t)(l * 16 + part) * 5) * 6144 + j;
            o[0] = s0; o[6144] = s1; o[2 * 6144] = s2; o[3 * 6144] = s3; o[4 * 6144] = s4;
        }
    }
    {
        const size_t gt = (size_t)blockIdx.x * 512 + tid, NT_ = (size_t)G * 512;
        bf16_t* T4 = (bf16_t*)(ws + WS_T4096); bf16_t* T2 = (bf16_t*)(ws + WS_TAB); bf16_t* CS = (bf16_t*)(ws + WS_TAB + 256 * 1024);
        for (size_t ch = gt; ch < (size_t)4096 * 512; ch += NT_) {
            const int k1 = (int)(ch >> 9), kk0 = (int)(ch & 511) * 8; float v[8];
#pragma unroll
            for (int e = 0; e < 8; ++e) { const int kk = kk0 + e, n1 = (kk <= 2048) ? kk : kk - 2048; const float fr_ = (float)((k1 * n1) & 4095) * (1.0f / 4096.0f);
                v[e] = (kk <= 2048) ? __builtin_amdgcn_cosf(fr_) * (1.0f / 64.0f) : -__builtin_amdgcn_sinf(fr_) * (1.0f / 64.0f); }
            u32x4 o; o.x = cvtpk(v[0], v[1]); o.y = cvtpk(v[2], v[3]); o.z = cvtpk(v[4], v[5]); o.w = cvtpk(v[6], v[7]);
            *(u32x4*)(T4 + ch * 8) = o;
        }
        for (size_t ch = gt; ch < (size_t)256 * 64; ch += NT_) {
            const int k1 = (int)(ch >> 6), kk0 = (int)(ch & 63) * 8; float v[8];
#pragma unroll
            for (int e = 0; e < 8; ++e) { const int kk = kk0 + e, n1 = kk & 255; const float fr_ = (float)((k1 * n1) & 255) * (1.0f / 256.0f);
                v[e] = (kk < 256) ? __builtin_amdgcn_cosf(fr_) * (1.0f / 16.0f) : -__builtin_amdgcn_sinf(fr_) * (1.0f / 16.0f); }
            u32x4 o; o.x = cvtpk(v[0], v[1]); o.y = cvtpk(v[2], v[3]); o.z = cvtpk(v[4], v[5]); o.w = cvtpk(v[6], v[7]);
            *(u32x4*)(T2 + ch * 8) = o;
        }
        for (size_t ch = gt; ch < (size_t)512 * 32; ch += NT_) {
            const int m = (int)(ch >> 5), c0 = (int)(ch & 31) * 8, k2 = m & 255; float v[8];
#pragma unroll
            for (int e = 0; e < 8; ++e) { const float fr_ = (float)((k2 * (c0 + e)) & 255) * (1.0f / 256.0f);
                v[e] = (m < 256) ? __builtin_amdgcn_cosf(fr_) * (1.0f / 16.0f) : __builtin_amdgcn_sinf(fr_) * (1.0f / 16.0f); }
            u32x4 o; o.x = cvtpk(v[0], v[1]); o.y = cvtpk(v[2], v[3]); o.z = cvtpk(v[4], v[5]); o.w = cvtpk(v[6], v[7]);
            *(u32x4*)(CS + ch * 8) = o;
        }
        float* RT = (float*)(ws + WS_TAB + 512 * 1024);
        if (gt < 1024) { const int pos = (int)(gt >> 4), j = (int)(gt & 15); float sn_, cs_; sincosf((float)pos * exp2f(-(float)j * (13.287712379549449f / 16.0f)), &sn_, &cs_); RT[gt] = cs_; RT[1024 + gt] = sn_; }
    }
}
__device__ __forceinline__ void phase_pre1(const Args& a) {
    const size_t gt = (size_t)blockIdx.x * 512 + threadIdx.x, NT_ = (size_t)gridDim.x * 512;
    const float* MODP = (const float*)(a.ws + WS_MODP); float* MOD = (float*)(a.ws + WS_MOD);
    for (size_t idx = gt; idx < (size_t)4 * 5 * 6144; idx += NT_) {
        const int l = (int)(idx / 30720), c = (int)((idx / 6144) % 5), j = (int)(idx % 6144);
        float s = a.in[11][l * 6144 + j];
#pragma unroll
        for (int p = 0; p < 16; ++p) s += MODP[((size_t)(l * 16 + p) * 5 + c) * 6144 + j];
        MOD[idx] = s;
    }
    if (gt < 4) { const int l = (int)gt; float s1 = 0.f, s2 = 0.f;
        for (int i = 0; i < 64; ++i) { s1 += a.in[16][l * 64 + i] * a.in[17][l * 64 + i]; s2 += a.in[18][l * 64 + i] * a.in[19][l * 64 + i]; }
        const float lam_init = 0.8f - 0.6f * expf(-0.3f * (float)l);
        MOD[4 * 5 * 6144 + l] = expf(s1) - expf(s2) + lam_init; }
}
__device__ __forceinline__ void phase_norm(const Args& a, int l) {
    int tid_ = threadIdx.x; asm volatile("" : "+v"(tid_));
    const int tid = tid_, lane = tid & 63, wave = tid >> 6, G = gridDim.x;
    const int gw = blockIdx.x * 8 + wave, NGW = G * 8;
    const float* MOD = (const float*)(a.ws + WS_MOD) + (size_t)l * 5 * 6144;
    const float* gn = a.in[12] + l * D;
    bf16_t* H = (bf16_t*)(a.ws + WS_H);
    for (int row = gw; row < NTOK; row += NGW) {
        const float* xrow = (l == 0) ? ((row < NPROMPT) ? a.in[0] + (size_t)row * D : a.in[1] + (size_t)(row - NPROMPT) * D) : a.out + (size_t)row * D;
        const int cv = (row < NPROMPT) ? 0 : 1 + ((row - NPROMPT) >> 12);
        const f32x4* xr = (const f32x4*)xrow + lane;
        f32x4 v[8]; float ss = 0.f;
#pragma unroll
        for (int j = 0; j < 8; ++j) { v[j] = xr[64 * j]; ss += (v[j].x * v[j].x + v[j].y * v[j].y) + (v[j].z * v[j].z + v[j].w * v[j].w); }
        const float rstd = 1.0f / sqrtf(wave_sum(ss) * (1.0f / D) + EPS);
        const float* sh = MOD + cv * 6144; const float* sc = sh + 2048;
#pragma unroll
        for (int j = 0; j < 8; ++j) { const int idx = (lane + 64 * j) * 4;
            const f32x4 g4 = *(const f32x4*)(gn + idx), s4 = *(const f32x4*)(sc + idx), h4 = *(const f32x4*)(sh + idx);
            const f32x4 o = v[j] * rstd * g4 * (s4 + 1.0f) + h4;
            u32x2 w; w.x = cvtpk(o.x, o.y); w.y = cvtpk(o.z, o.w);
            *(u32x2*)(H + (size_t)row * D + idx) = w; }
    }
    const size_t gt = (size_t)blockIdx.x * 512 + tid, NT_ = (size_t)G * 512;
    bf16_t* KCs = (bf16_t*)(a.ws + WS_KC) + (size_t)PB * 8 * 2 * PSEQ * 64;
    bf16_t* VTs = (bf16_t*)(a.ws + WS_VT) + (size_t)PB * 8 * 128 * PSEQ;
    for (size_t ch = gt; ch < (size_t)SB * PAST * 128; ch += NT_) {
        const int c8 = (int)(ch & 7), hc = (int)((ch >> 3) & 15), key = (int)((ch >> 7) & 511), b = (int)(ch >> 16);
        const float* src = a.in[3] + (((size_t)(b * DEPTH + l) * PAST + key) * 1024 + hc * 64 + c8 * 8);
        const f32x4 x0 = *(const f32x4*)src, x1 = *(const f32x4*)(src + 4);
        u32x4 w; w.x = cvtpk(x0.x, x0.y); w.y = cvtpk(x0.z, x0.w); w.z = cvtpk(x1.x, x1.y); w.w = cvtpk(x1.z, x1.w);
        *(u32x4*)(KCs + (((size_t)(b * 16 + hc)) * SNK + key) * 64 + c8 * 8) = w;
    }
    for (size_t ch = gt; ch < (size_t)SB * 8 * 64 * 128; ch += NT_) {
        const int d = (int)(ch & 127), pc = (int)((ch >> 7) & 63), h = (int)((ch >> 13) & 7), b = (int)(ch >> 16);
        const int s = pc >> 1, hf = pc & 1; float v[8];
#pragma unroll
        for (int i = 0; i < 8; ++i) { const int key = 16 * s + 8 * (i >> 2) + 4 * hf + (i & 3);
            v[i] = a.in[4][((size_t)(b * DEPTH + l) * PAST + key) * 1024 + h * 128 + d]; }
        u32x4 w; w.x = cvtpk(v[0], v[1]); w.y = cvtpk(v[2], v[3]); w.z = cvtpk(v[4], v[5]); w.w = cvtpk(v[6], v[7]);
        *(u32x4*)(VTs + ((size_t)(b * 8 + h) * 128 + d) * SNK + pc * 8) = w;
    }
}
__device__ __forceinline__ void phase_prep(const Args& a, int l, LAS unsigned char* lds) {
    int tid_ = threadIdx.x; asm volatile("" : "+v"(tid_));
    const int tid = tid_, lane = tid & 63, wave = tid >> 6, G = gridDim.x;
    const int gw = blockIdx.x * 8 + wave, NGW = G * 8;
    const bf16_t* P = (const bf16_t*)(a.ws + WS_P);
    bf16_t* QN = (bf16_t*)(a.ws + WS_QN); bf16_t* KC = (bf16_t*)(a.ws + WS_KC); bf16_t* VT = (bf16_t*)(a.ws + WS_VT);
    float* ock = a.out + (size_t)41943040; float* ocv = a.out + (size_t)58720256;
    for (int item = blockIdx.x; item < 2560; item += G) {
        const int tb = item >> 3, h = item & 7, tok0 = tb * 64;
        const bool smp = tok0 >= NPROMPT;
        int b, n0, Nk, koff; size_t vbase;
        if (!smp) { b = tok0 >> 8; n0 = tok0 & 255; Nk = PSEQ; koff = 0; vbase = 0; }
        else { const int r2 = tok0 - NPROMPT; b = r2 >> 12; n0 = r2 & 4095; Nk = SNK; koff = PAST; vbase = (size_t)PB * 8 * 128 * PSEQ; }
        __syncthreads();
#pragma unroll
        for (int i = 0; i < 2; ++i) { const int piece = tid + 512 * i, r = piece >> 4, cc = piece & 15;
            const u32x4 v = *(const u32x4*)(P + (size_t)(tok0 + r) * INC + C_V + h * 128 + cc * 8);
            *(LAS u32x4*)(lds + r * 272 + cc * 16) = v;
            if (!smp) { float f[8]; unpack8(v, f); float* o = ocv + ((size_t)(b * DEPTH + l) * PSEQ + n0 + r) * 1024 + h * 128 + cc * 8;
                *(f32x4*)o = (f32x4){f[0], f[1], f[2], f[3]}; *(f32x4*)(o + 4) = (f32x4){f[4], f[5], f[6], f[7]}; } }
        __syncthreads();
#pragma unroll
        for (int i = 0; i < 2; ++i) { const int oc = tid + 512 * i, d = oc >> 3, pc = oc & 7, s = pc >> 1, hf = pc & 1;
            unsigned short e[8];
#pragma unroll
            for (int j = 0; j < 8; ++j) { const int key = 16 * s + 8 * (j >> 2) + 4 * hf + (j & 3); e[j] = *(const LAS unsigned short*)(lds + key * 272 + d * 2); }
            u32x4 w; w.x = e[0] | ((unsigned)e[1] << 16); w.y = e[2] | ((unsigned)e[3] << 16); w.z = e[4] | ((unsigned)e[5] << 16); w.w = e[6] | ((unsigned)e[7] << 16);
            *(u32x4*)(VT + vbase + ((size_t)(b * 8 + h) * 128 + d) * Nk + koff + n0 + pc * 8) = w; }
    }
    __syncthreads();
}

__device__ __forceinline__ void phase_fold(const Args& a) {
    int tid_ = threadIdx.x; asm volatile("" : "+v"(tid_));
    const size_t gt = (size_t)blockIdx.x * 512 + tid_, NT_ = (size_t)gridDim.x * 512;
    const bf16_t* ABTs = (const bf16_t*)(a.ws + WS_ABT) + (size_t)PB * 1024 * 512;
    bf16_t* FB = (bf16_t*)(a.ws + WS_T4096 + 32 * MiB);
    for (size_t ch = gt; ch < (size_t)SB * 1024 * 512; ch += NT_) {
        const int kk0 = (int)(ch & 511) * 8; const size_t row = ch >> 9;
        const bf16_t* A = ABTs + row * 8192; const bf16_t* B = A + 4096;
        const bool apart = kk0 < 2048; const bf16_t* X = apart ? A : B; const int f0 = apart ? kk0 : kk0 - 2048;
        float fw[8], mr[8]; unpack8(*(const u32x4*)(X + f0), fw); unpack8(*(const u32x4*)(X + 4096 - f0 - 8), mr);
        const float m0 = (f0 > 0) ? bf2f(X[4096 - f0]) : 0.f;
        float v[8];
        if (apart) { v[0] = (f0 == 0) ? fw[0] : fw[0] + m0;
#pragma unroll
            for (int e = 1; e < 8; ++e) v[e] = fw[e] + mr[8 - e]; }
        else { v[0] = (f0 == 0) ? bf2f(A[2048]) : fw[0] - m0;
#pragma unroll
            for (int e = 1; e < 8; ++e) v[e] = fw[e] - mr[8 - e]; }
        u32x4 o; o.x = cvtpk(v[0], v[1]); o.y = cvtpk(v[2], v[3]); o.z = cvtpk(v[4], v[5]); o.w = cvtpk(v[6], v[7]);
        *(u32x4*)(FB + row * 4096 + kk0) = o;
    }
}

__device__ __forceinline__ void attn_item(LAS unsigned char* lds, const bf16_t* Q, int Nq, const bf16_t* Kc, const bf16_t* Vt, int Nk, int q0,
                                          float lam, float onorm, const float* gsub, const bf16_t* za, bf16_t* Yo) {
    int tid_ = threadIdx.x; asm volatile("" : "+v"(tid_));
    const int tid = tid_, lane = tid & 63, wave = __builtin_amdgcn_readfirstlane(tid >> 6), r32 = lane & 31, hi = lane >> 5, c = wave >> 2, qs = wave & 3;
    bf16x8 qr[4];
    { const bf16_t* qp = Q + ((size_t)c * Nq + q0 + qs * 32 + r32) * 64 + hi * 8;
#pragma unroll
      for (int d0 = 0; d0 < 4; ++d0) qr[d0] = *(const bf16x8*)(qp + d0 * 16); }
    const int srow = wave * 8 + (lane >> 3), sch = (lane & 7) ^ ((srow >> 1) & 7);
    const bf16_t* k0src = Kc + (size_t)srow * 64 + sch * 8; const bf16_t* k1src = k0src + (size_t)Nk * 64;
    const bf16_t* v0src = Vt + (size_t)srow * Nk + sch * 8; const bf16_t* v1src = v0src + (size_t)64 * Nk;
    const int wpiece = wave * 1024;
#define ATT_DMA(stgoff, tt) do { \
        __builtin_amdgcn_global_load_lds((const unsigned*)(k0src + (size_t)(tt) * 4096), (LAS unsigned*)(lds + (stgoff) + wpiece), 16, 0, 0); \
        __builtin_amdgcn_global_load_lds((const unsigned*)(k1src + (size_t)(tt) * 4096), (LAS unsigned*)(lds + (stgoff) + 8192 + wpiece), 16, 0, 0); \
        __builtin_amdgcn_global_load_lds((const unsigned*)(v0src + (size_t)(tt) * 64), (LAS unsigned*)(lds + (stgoff) + 16384 + wpiece), 16, 0, 0); \
        __builtin_amdgcn_global_load_lds((const unsigned*)(v1src + (size_t)(tt) * 64), (LAS unsigned*)(lds + (stgoff) + 24576 + wpiece), 16, 0, 0); } while (0)
    const int swz = (r32 >> 1) & 7; int xo[4];
#pragma unroll
    for (int j = 0; j < 4; ++j) xo[j] = ((2 * j + hi) ^ swz) * 16;
    const int kro = c * 8192 + r32 * 128, vro = 16384 + r32 * 128;
    const int NT = Nk >> 6;
    ATT_DMA(0, 0);
    __syncthreads();
    f32x16 O[4];
#pragma unroll
    for (int i = 0; i < 4; ++i)
#pragma unroll
        for (int r = 0; r < 16; ++r) O[i][r] = 0.f;
    f32x16 negm;
#pragma unroll
    for (int r = 0; r < 16; ++r) negm[r] = 0.f;
    float m = 0.f, lsum = 0.f;
    bf16x8 pf[4];
#pragma unroll
    for (int i = 0; i < 4; ++i) pf[i] = (bf16x8){0, 0, 0, 0, 0, 0, 0, 0};
#define ATT_VLD(dst, stg, db) do { _Pragma("unroll") for (int i_ = 0; i_ < 4; ++i_) dst[i_] = *(const LAS bf16x8*)((stg) + vro + (db) * 4096 + xo[i_]); } while (0)
#define ATT_PVM(src, db) do { __builtin_amdgcn_s_setprio(1); _Pragma("unroll") for (int i_ = 0; i_ < 4; ++i_) O[db] = __builtin_amdgcn_mfma_f32_32x32x16_bf16(src[i_], pf[i_], O[db], 0, 0, 0); __builtin_amdgcn_s_setprio(0); } while (0)
#define SCHEDB() __builtin_amdgcn_sched_barrier(0)
    int so_prev = 65536, so_cur = 0, so_next = 32768;
    bf16x8 va[4], vb[4];
    for (int t = 0; t < NT; ++t) {
        LAS unsigned char* cur = lds + so_cur;
        if (t + 1 < NT) ATT_DMA(so_next, t + 1);
        bf16x8 kf[8];
        if (c == 1 && t > 0) { LAS unsigned char* prv = lds + so_prev;
            ATT_VLD(va, prv, 0); SCHEDB(); ATT_VLD(vb, prv, 1); SCHEDB();
            ATT_PVM(va, 0); SCHEDB(); ATT_VLD(va, prv, 2); SCHEDB();
            ATT_PVM(vb, 1); SCHEDB(); ATT_VLD(vb, prv, 3); SCHEDB();
            ATT_PVM(va, 2); SCHEDB();
#pragma unroll
            for (int d0 = 0; d0 < 4; ++d0) { kf[2 * d0] = *(const LAS bf16x8*)(cur + kro + xo[d0]); kf[2 * d0 + 1] = *(const LAS bf16x8*)(cur + kro + 4096 + xo[d0]); }
            SCHEDB(); ATT_PVM(vb, 3); SCHEDB();
        } else {
#pragma unroll
            for (int d0 = 0; d0 < 4; ++d0) { kf[2 * d0] = *(const LAS bf16x8*)(cur + kro + xo[d0]); kf[2 * d0 + 1] = *(const LAS bf16x8*)(cur + kro + 4096 + xo[d0]); }
            SCHEDB();
        }
        f32x16 S0, S1;
        __builtin_amdgcn_s_setprio(1);
        S0 = __builtin_amdgcn_mfma_f32_32x32x16_bf16(kf[0], qr[0], negm, 0, 0, 0);
        S1 = __builtin_amdgcn_mfma_f32_32x32x16_bf16(kf[1], qr[0], negm, 0, 0, 0);
#pragma unroll
        for (int d0 = 1; d0 < 4; ++d0) {
            S0 = __builtin_amdgcn_mfma_f32_32x32x16_bf16(kf[2 * d0], qr[d0], S0, 0, 0, 0);
            S1 = __builtin_amdgcn_mfma_f32_32x32x16_bf16(kf[2 * d0 + 1], qr[d0], S1, 0, 0, 0);
        }
        __builtin_amdgcn_s_setprio(0);
        SCHEDB();
        if (c == 0) { ATT_VLD(va, cur, 0); SCHEDB(); }
        float mx = fmaxf(S0[0], S1[0]);
#pragma unroll
        for (int r = 1; r < 16; ++r) mx = fmaxf(mx, fmaxf(S0[r], S1[r]));
        mx = fmaxf(mx, __shfl_xor(mx, 32));
        if (__any(mx > 8.0f)) {
            const float dl = fmaxf(mx, 0.f), al = __builtin_amdgcn_exp2f(-dl); m += dl; lsum *= al;
#pragma unroll
            for (int r = 0; r < 16; ++r) { S0[r] -= dl; S1[r] -= dl; negm[r] = -m; }
#pragma unroll
            for (int i = 0; i < 4; ++i)
#pragma unroll
                for (int r = 0; r < 16; ++r) O[i][r] *= al;
        }
        float ps = 0.f;
#pragma unroll
        for (int r = 0; r < 16; ++r) { S0[r] = __builtin_amdgcn_exp2f(S0[r]); S1[r] = __builtin_amdgcn_exp2f(S1[r]); ps += S0[r] + S1[r]; }
        lsum += ps;
        { u32x4 w;
          w.x = cvtpk(S0[0], S0[1]); w.y = cvtpk(S0[2], S0[3]); w.z = cvtpk(S0[4], S0[5]); w.w = cvtpk(S0[6], S0[7]); pf[0] = __builtin_bit_cast(bf16x8, w);
          w.x = cvtpk(S0[8], S0[9]); w.y = cvtpk(S0[10], S0[11]); w.z = cvtpk(S0[12], S0[13]); w.w = cvtpk(S0[14], S0[15]); pf[1] = __builtin_bit_cast(bf16x8, w);
          w.x = cvtpk(S1[0], S1[1]); w.y = cvtpk(S1[2], S1[3]); w.z = cvtpk(S1[4], S1[5]); w.w = cvtpk(S1[6], S1[7]); pf[2] = __builtin_bit_cast(bf16x8, w);
          w.x = cvtpk(S1[8], S1[9]); w.y = cvtpk(S1[10], S1[11]); w.z = cvtpk(S1[12], S1[13]); w.w = cvtpk(S1[14], S1[15]); pf[3] = __builtin_bit_cast(bf16x8, w); }
        if (c == 0) { SCHEDB(); ATT_VLD(vb, cur, 1); SCHEDB(); ATT_PVM(va, 0); SCHEDB(); ATT_VLD(va, cur, 2); SCHEDB(); ATT_PVM(vb, 1); SCHEDB(); ATT_VLD(vb, cur, 3); SCHEDB(); ATT_PVM(va, 2); SCHEDB(); ATT_PVM(vb, 3); SCHEDB(); }
        __syncthreads();
        { const int tmp = so_prev; so_prev = so_cur; so_cur = so_next; so_next = tmp; }
    }
    if (c == 1) { LAS unsigned char* prv = lds + so_prev; ATT_VLD(va, prv, 0); ATT_VLD(vb, prv, 1); ATT_PVM(va, 0); ATT_VLD(va, prv, 2); ATT_PVM(vb, 1); ATT_VLD(vb, prv, 3); ATT_PVM(va, 2); ATT_PVM(vb, 3); }
#undef ATT_VLD
#undef ATT_DMA
#undef ATT_PVM
#undef SCHEDB
    __syncthreads();
    lsum += __shfl_xor(lsum, 32);
    const float il = 1.0f / lsum;
    LAS float* xb = (LAS float*)(lds + 65536) + qs * 4096;
    if (c == 1) {
#pragma unroll
        for (int db = 0; db < 4; ++db)
#pragma unroll
            for (int r = 0; r < 16; ++r) xb[(db * 16 + r) * 64 + lane] = O[db][r] * il;
    }
    __syncthreads();
    if (c == 0) {
        float ss = 0.f;
#pragma unroll
        for (int db = 0; db < 4; ++db)
#pragma unroll
            for (int r = 0; r < 16; ++r) { const float o = O[db][r] * il - lam * xb[(db * 16 + r) * 64 + lane]; O[db][r] = o; ss += o * o; }
        ss += __shfl_xor(ss, 32);
        const float rs = onorm / sqrtf(ss * (1.0f / 128.0f) + EPS);
        const int tok = q0 + qs * 32 + r32;
        const bf16_t* zr = za + (size_t)tok * INC; bf16_t* yo = Yo + (size_t)tok * D;
#pragma unroll
        for (int db = 0; db < 4; ++db)
#pragma unroll
            for (int g = 0; g < 4; ++g) { const int d = 32 * db + 8 * g + 4 * hi;
                const f32x4 gs = *(const f32x4*)(gsub + d); const u32x2 z = *(const u32x2*)(zr + d);
                const float o0 = O[db][4 * g] * rs * gs.x * bf2f(z.x & 0xffffu), o1 = O[db][4 * g + 1] * rs * gs.y * bf2f(z.x >> 16);
                const float o2 = O[db][4 * g + 2] * rs * gs.z * bf2f(z.y & 0xffffu), o3 = O[db][4 * g + 3] * rs * gs.w * bf2f(z.y >> 16);
                u32x2 w; w.x = cvtpk(o0, o1); w.y = cvtpk(o2, o3); *(u32x2*)(yo + d) = w; }
    }
    __syncthreads();
}
__device__ __forceinline__ void phase_attn(const Args& a, int l, LAS unsigned char* lds) {
    const int G = gridDim.x;
    const bf16_t* P = (const bf16_t*)(a.ws + WS_P); bf16_t* Y = (bf16_t*)(a.ws + WS_Y);
    const bf16_t* QN = (const bf16_t*)(a.ws + WS_QN); const bf16_t* KC = (const bf16_t*)(a.ws + WS_KC); const bf16_t* VT = (const bf16_t*)(a.ws + WS_VT);
    const float lam = ((const float*)(a.ws + WS_MOD))[4 * 5 * 6144 + l];
    const float lam_init = 0.8f - 0.6f * expf(-0.3f * (float)l);
    const float* gsub = a.in[15] + l * 128;
    for (int L = blockIdx.x; L < 1280; L += G) {
        if (L < 1024) { const int b = L >> 8, h = L & 7, qb = (L >> 3) & 31;
            const size_t qoff = (size_t)PB * 16 * PSEQ * 64 + (size_t)(b * 8 + h) * 2 * SSEQ * 64;
            const size_t koff = (size_t)PB * 16 * PSEQ * 64 + (size_t)(b * 8 + h) * 2 * SNK * 64;
            const size_t voff = (size_t)PB * 8 * 128 * PSEQ + (size_t)(b * 8 + h) * 128 * SNK;
            const size_t tok0 = (size_t)NPROMPT + (size_t)b * SSEQ;
            attn_item(lds, QN + qoff, SSEQ, KC + koff, VT + voff, SNK, qb * 128, lam, 1.0f - lam_init, gsub + 0, P + tok0 * INC + C_ZA + h * 128, Y + tok0 * D + 1024 + h * 128);
        } else { const int M_ = L - 1024, b = M_ >> 4, h = (M_ >> 1) & 7, qb = M_ & 1;
            const size_t qoff = (size_t)(b * 8 + h) * 2 * PSEQ * 64, voff = (size_t)(b * 8 + h) * 128 * PSEQ;
            const size_t tok0 = (size_t)b * PSEQ;
            attn_item(lds, QN + qoff, PSEQ, KC + qoff, VT + voff, PSEQ, qb * 128, lam, 1.0f - lam_init, gsub + 0, P + tok0 * INC + C_ZA + h * 128, Y + tok0 * D + 1024 + h * 128);
        }
    }
}

#define XB_TMO      128
#define XB_XCNT(j)  (256  + 64 * (j))
#define XB_XSUB(j)  (1280 + 64 * (j))
#define XB_XGEN(j)  (2304 + 64 * (j))
#define XB_TOP      3328
#define XB_TOPGEN   3392
#define XCD_BAR_WORDS 3456
#define XB_SPIN_CAP (1u << 20)
__device__ __forceinline__ unsigned xb_ld(unsigned* p)              { return __hip_atomic_load(p, __ATOMIC_RELAXED, __HIP_MEMORY_SCOPE_AGENT); }
__device__ __forceinline__ unsigned xb_add(unsigned* p, unsigned v) { return __hip_atomic_fetch_add(p, v, __ATOMIC_RELAXED, __HIP_MEMORY_SCOPE_AGENT); }
__device__ __forceinline__ unsigned xb_xcc_id() { return (unsigned)__builtin_amdgcn_s_getreg((3 << 11) | 20) & 0xFu; }
#define XB_SPIN(cond, bar) do { unsigned _sp = 0; while (cond) { __builtin_amdgcn_s_sleep(1); \
    if ((++_sp & 255u) == 0u) { if (xb_ld(&(bar)[XB_TMO])) break; if (_sp > XB_SPIN_CAP) { atomicAdd(&(bar)[XB_TMO], 1u); break; } } } } while (0)
struct XcdBarrier { unsigned* bar; unsigned x; volatile LAS unsigned* st; };
__device__ __forceinline__ XcdBarrier xcd_barrier_post(unsigned* bar, volatile LAS unsigned* st) {
    XcdBarrier b; b.bar = bar; b.x = xb_xcc_id(); b.st = st;
    if (threadIdx.x == 0) (void)xb_add(&bar[XB_XCNT(b.x)], 1u);
    return b;
}
__device__ __forceinline__ void xcd_barrier_complete(unsigned* bar, unsigned x, unsigned& nloc, unsigned& nx) {
    const unsigned G = gridDim.x * gridDim.y * gridDim.z;
    unsigned sum, cnt, mine, sp = 0u;
    for (;;) {
        sum = 0u; cnt = 0u; mine = 0u;
#pragma unroll
        for (unsigned j = 0; j < 16; ++j) { const unsigned c = xb_ld(&bar[XB_XCNT(j)]); sum += c; cnt += (c > 0u) ? 1u : 0u; mine = (j == x) ? c : mine; }
        if (sum == G) break;
        __builtin_amdgcn_s_sleep(1);
        if ((++sp & 255u) == 0u) { if (xb_ld(&bar[XB_TMO])) break; if (sp > XB_SPIN_CAP) { atomicAdd(&bar[XB_TMO], 1u); break; } }
    }
    nloc = mine > 0u ? mine : 1u; nx = cnt > 0u ? cnt : 1u;
}
__device__ __forceinline__ void xcd_barrier(const XcdBarrier& b) {
    asm volatile("s_waitcnt vmcnt(0)" ::: "memory");
    __syncthreads();
    if (threadIdx.x == 0) {
        unsigned* bar = b.bar;
        __builtin_amdgcn_s_waitcnt(0);
        unsigned nloc = b.st[0], nx = b.st[1];
        if (nloc == 0u) { xcd_barrier_complete(bar, b.x, nloc, nx); b.st[0] = nloc; b.st[1] = nx; }
        const unsigned old = xb_add(&bar[XB_XSUB(b.x)], 1u);
        const unsigned gen = old / nloc;
        if (old + 1u == (gen + 1u) * nloc) {
            __builtin_amdgcn_fence(__ATOMIC_RELEASE, "agent");
            asm volatile("s_waitcnt vmcnt(0)" ::: "memory");
            const unsigned og = xb_add(&bar[XB_TOP], 1u);
            const unsigned tg = og / nx;
            if (og + 1u == (tg + 1u) * nx) xb_add(&bar[XB_TOPGEN], 1u);
            else XB_SPIN(xb_ld(&bar[XB_TOPGEN]) == tg, bar);
            __builtin_amdgcn_fence(__ATOMIC_ACQUIRE, "agent");
            xb_add(&bar[XB_XGEN(b.x)], 1u);
            asm volatile("s_waitcnt vmcnt(0)" ::: "memory");
        } else {
            XB_SPIN(xb_ld(&bar[XB_XGEN(b.x)]) == gen, bar);
            __builtin_amdgcn_fence(__ATOMIC_ACQUIRE, "agent");
            asm volatile("s_waitcnt vmcnt(0)" ::: "memory");
        }
    }
    __syncthreads();
}

#ifndef PHMASK
#define PHMASK 0xFFFF
#endif
#define REP_IN 1
#define REP_ATTN 1
#define REP_POS 1
#define REP_PREP 1
#define REP_MERGE 1
#define REP_PRE0 1
#define REP_NORM 1
#define REP_CHAN 1
__global__ void __launch_bounds__(512, 2) fwd_kernel(Args a) {
    extern __shared__ __attribute__((aligned(16))) unsigned char lds_raw[];
    LAS unsigned char* lds = (LAS unsigned char*)lds_raw;
    cg::grid_group grid = cg::this_grid();
    const int G = gridDim.x, c = blockIdx.x;
    unsigned char* ws = a.ws;
    int ph = 0;
    volatile LAS unsigned* bst = (volatile LAS unsigned*)(lds + 131072 + 512);
    if (threadIdx.x < 2) bst[threadIdx.x] = 0u;
    __syncthreads();
    const XcdBarrier xbar = xcd_barrier_post((unsigned*)(ws + WS_CTL), bst);
#define SEAM() do { if (a.ph_lo <= ph && ph + 1 < a.ph_hi) { if (ph == 0) grid.sync(); else xcd_barrier(xbar); } ++ph; } while (0)
#define IN_PH() (a.ph_lo <= ph && ph < a.ph_hi)
    if (IN_PH()) { if constexpr (PHMASK & 1) for (int rep = 0; rep < REP_PRE0; ++rep) { phase_pre0(a, lds); __syncthreads(); } }
    SEAM();
    if (IN_PH()) { if constexpr (PHMASK & 2) phase_pre1(a); }
    SEAM();
#pragma unroll 1
    for (int l = 0; l < DEPTH; ++l) {
        if (IN_PH()) { if constexpr (PHMASK & 4) for (int rep = 0; rep < REP_NORM; ++rep) phase_norm(a, l); }
        SEAM();
        const char* Hb = (const char*)(ws + WS_H); const char* WIl = (const char*)(ws + WS_WIN) + (size_t)l * INC * D * 2; const size_t trs_ = (size_t)256 * D * 2;
        const EpiIn EI{(bf16_t*)(ws + WS_P), (bf16_t*)(ws + WS_QN), (bf16_t*)(ws + WS_KC), a.out + (size_t)41943040, a.in[13] + l * 64, a.in[14] + l * 64, (const float*)(ws + WS_TAB + 512 * 1024), l, ws + WS_GN, ws + WS_ZN};
        const pg8::Gemm gI{D, D, D};
        if (IN_PH()) if constexpr (PHMASK & 8) {
            { pg8::Order<pg8::MapGrid> S{80 * 32, G, c, pg8::MapGrid{Hb, WIl, 80, 32, trs_, trs_, 0, 0}};
              for (int rep = 0; rep < REP_IN; ++rep) pg8::gemm_phase(lds, gI, S, EI); }
            { pg8::Order<pg8::MapGrid> S{64 * 8, G, c, pg8::MapGrid{Hb, WIl, 64, 8, trs_, trs_, 0, 32}};
              pg8::gemm_phase(lds, gI, S, EI); }
        }
        SEAM();
        if (IN_PH()) if constexpr (PHMASK & 16) {
            if (c < (G >> 1)) { pg8::Order<pg8::MapGrid> S{16 * 8, G >> 1, c, pg8::MapGrid{Hb, WIl, 16, 8, trs_, trs_, 64, 32}}; pg8::gemm_phase(lds, gI, S, EI); }
            else { pg8::Gemm g{256, INC, 256};
                pg8::Order<MapChan> S{640, G - (G >> 1), c - (G >> 1), MapChan{(const char*)(ws + WS_TAB + 256 * 1024), (const char*)(ws + WS_P)}};
                EpiStore E{(bf16_t*)(ws + WS_ABT)};
                for (int rep = 0; rep < REP_CHAN; ++rep) pg8::gemm_phase(lds, g, S, E); }
        }
        SEAM();
        if (IN_PH()) {
            if constexpr (PHMASK & 32) for (int rep = 0; rep < REP_PREP; ++rep) phase_prep(a, l, lds);
            phase_fold(a);
        }
        SEAM();
        if (IN_PH()) if constexpr (PHMASK & 64) {
            { pg8::Gemm g{4096, 4096, 4096};
              pg8::Order<MapPosS> S{256, G, c, MapPosS{(const char*)(ws + WS_T4096), (const char*)(ws + WS_T4096 + 32 * MiB)}};
              EpiPos E{ws + WS_ZN, (bf16_t*)(ws + WS_Y)};
              for (int rep = 0; rep < REP_POS; ++rep) pg8::gemm_phase(lds, g, S, E); }
            { pg8::Gemm g{512, 512, 512};
              pg8::Order<MapPosP> S{64, G, c, MapPosP{(const char*)(ws + WS_TAB), (const char*)(ws + WS_ABT)}};
              EpiPos E{ws + WS_ZN, (bf16_t*)(ws + WS_Y)};
              pg8::gemm_phase(lds, g, S, E); }
            if constexpr (PHMASK & 128) for (int rep = 0; rep < REP_ATTN; ++rep) phase_attn(a, l, lds);
        }
        SEAM();
        const char* Yb = (const char*)(ws + WS_Y); const char* MGb = (const char*)(ws + WS_H);
        const char* WMl = (const char*)(ws + WS_WM) + (size_t)l * D * D * 2; const char* WOl = (const char*)(ws + WS_WO) + (size_t)l * D * D * 2;
        const size_t trs = (size_t)256 * D * 2;
        const EpiMerge EM{ws + WS_GN, (bf16_t*)(ws + WS_H)};
        const EpiOut EO{(l == 0) ? a.in[0] : a.out, (l == 0) ? a.in[1] : a.out + (size_t)NPROMPT * D, a.out, (const float*)(ws + WS_MOD) + (size_t)l * 5 * 6144};
        const pg8::Gemm gD{D, D, D};
        if (IN_PH()) if constexpr (PHMASK & 256) {
            pg8::Order<pg8::MapGrid> S{64 * 8, G, c, pg8::MapGrid{Yb, WMl, 64, 8, trs, trs, 0, 0}};
            for (int rep = 0; rep < REP_MERGE; ++rep) pg8::gemm_phase(lds, gD, S, EM);
        }
        SEAM();
        if (IN_PH()) if constexpr (PHMASK & 512) {
            if (c < (G >> 1)) { pg8::Order<pg8::MapGrid> S{16 * 8, G >> 1, c, pg8::MapGrid{Yb, WMl, 16, 8, trs, trs, 64, 0}}; pg8::gemm_phase(lds, gD, S, EM); }
            else { pg8::Order<pg8::MapGrid> S{16 * 8, G - (G >> 1), c - (G >> 1), pg8::MapGrid{MGb, WOl, 16, 8, trs, trs, 0, 0}}; pg8::gemm_phase(lds, gD, S, EO); }
        }
        SEAM();
        if (IN_PH()) if constexpr (PHMASK & 512) {
            pg8::Order<pg8::MapGrid> S{64 * 8, G, c, pg8::MapGrid{MGb, WOl, 64, 8, trs, trs, 16, 0}};
            pg8::gemm_phase(lds, gD, S, EO);
        }
        SEAM();
    }
#undef SEAM
#undef IN_PH
}
constexpr int N_PHASES = 2 + 8 * DEPTH;

extern "C" void kernel_launch(void* const* d_in, const int* in_sizes, int n_in, void* d_out, int out_size, void* d_ws, size_t ws_size, hipStream_t stream) {
    static int grid = 0;
    if (grid == 0) {
        if (n_in != 20 || ws_size < WS_END) { fprintf(stderr, "kernel_launch: unexpected n_in %d or ws_size %zu (< %zu)\n", n_in, ws_size, (size_t)WS_END); grid = -1; return; }
        int dev = 0, cus = 0, per_cu = 0;
        hipGetDevice(&dev); hipDeviceGetAttribute(&cus, hipDeviceAttributeMultiprocessorCount, dev);
        if (hipFuncSetAttribute((const void*)fwd_kernel, hipFuncAttributeMaxDynamicSharedMemorySize, LDS_BYTES) != hipSuccess) { fprintf(stderr, "kernel_launch: hipFuncSetAttribute failed\n"); grid = -1; return; }
        hipOccupancyMaxActiveBlocksPerMultiprocessor(&per_cu, (const void*)fwd_kernel, 512, LDS_BYTES);
        (void)hipGetLastError();
        if (per_cu < 1) { fprintf(stderr, "kernel_launch: occupancy query says %d blocks per CU\n", per_cu); per_cu = 1; }
        grid = cus * 1;
    }
    if (grid < 0) return;
    if (hipMemsetAsync((char*)d_ws + WS_CTL, 0, XCD_BAR_WORDS * 4, stream) != hipSuccess) { fprintf(stderr, "kernel_launch: hipMemsetAsync failed\n"); return; }
    Args a{};
    for (int i = 0; i < 20; ++i) a.in[i] = (const float*)d_in[i];
    a.out = (float*)d_out; a.ws = (unsigned char*)d_ws; a.ph_lo = 0; a.ph_hi = N_PHASES;
    void* params[] = {&a};
    hipError_t e = hipLaunchCooperativeKernel((const void*)fwd_kernel, dim3(grid), dim3(512), params, LDS_BYTES, stream);
    if (e != hipSuccess) fprintf(stderr, "cooperative launch failed: %s (grid %d)\n", hipGetErrorString(e), grid);
}
```

```cpp
#include <hip/hip_runtime.h>
#include <hip/hip_cooperative_groups.h>
#include <cstdio>
#include <cstdint>
namespace cg = cooperative_groups;

#define LAS __attribute__((address_space(3)))
typedef unsigned short bf16_t;
typedef short bf16x8 __attribute__((ext_vector_type(8)));
typedef float f32x2 __attribute__((ext_vector_type(2)));
typedef float f32x4 __attribute__((ext_vector_type(4)));
typedef float f32x16 __attribute__((ext_vector_type(16)));
typedef unsigned u32x2 __attribute__((ext_vector_type(2)));
typedef unsigned u32x4 __attribute__((ext_vector_type(4)));
typedef __bf16 bf16x2_t __attribute__((ext_vector_type(2)));

constexpr int D = 2048, DEPTH = 4, NTOK = 20480, NPROMPT = 4096, INC = 10240;
constexpr int PB = 16, PSEQ = 256, SB = 4, SSEQ = 4096, PAST = 512, SNK = PAST + SSEQ;
constexpr int C_UF = 0, C_ZF = 1024, C_Q = 2048, C_K = 3072, C_V = 4096, C_ZA = 5120, C_GF = 6144, C_GA = 8192;
constexpr float EPS = 1e-6f;
constexpr float LOG2E = 1.4426950408889634f;
constexpr float QSCALE = 0.125f * LOG2E;

constexpr size_t MiB = 1u << 20;
constexpr size_t WS_CTL = 0;
constexpr size_t WS_WIN = 1 * MiB;
constexpr size_t WS_WM = WS_WIN + 160 * MiB;
constexpr size_t WS_WO = WS_WM + 32 * MiB;
constexpr size_t WS_MODP = WS_WO + 32 * MiB;
constexpr size_t WS_MOD = WS_MODP + 8 * MiB;
constexpr size_t WS_TAB = WS_MOD + 1 * MiB;
constexpr size_t WS_T4096 = WS_TAB + 1 * MiB;
constexpr size_t WS_H = WS_T4096 + 64 * MiB;
constexpr size_t WS_P = WS_H + 80 * MiB;
constexpr size_t WS_ABT = WS_P + 400 * MiB;
constexpr size_t WS_Y = WS_ABT + 80 * MiB;
constexpr size_t WS_QN = WS_Y + 80 * MiB;
constexpr size_t WS_KC = WS_QN + 40 * MiB;
constexpr size_t WS_VT = WS_KC + 44 * MiB;
constexpr size_t WS_GN = WS_VT + 44 * MiB;
constexpr size_t WS_ZN = WS_GN + 160 * MiB;
constexpr size_t WS_END = WS_ZN + 40 * MiB;
__device__ __forceinline__ size_t nat_off(int tile, int ai, int m, int bj, int wave, int lane) { return ((((size_t)tile * 8 + ai * 4 + m) * 2 + bj) * 8 + wave) * 1024 + (size_t)lane * 16; }
constexpr int LDS_BYTES = 147456;

__device__ __forceinline__ float bf2f(unsigned b) { return __uint_as_float(b << 16); }
__device__ __forceinline__ unsigned cvtpk(float lo, float hi) { f32x2 v = {lo, hi}; bf16x2_t b = __builtin_convertvector(v, bf16x2_t); return __builtin_bit_cast(unsigned, b); }
__device__ __forceinline__ float sigmoidf_(float x) { return __builtin_amdgcn_rcpf(1.0f + __builtin_amdgcn_exp2f(-x * LOG2E)); }
__device__ __forceinline__ float siluf_(float x) { return x * sigmoidf_(x); }
__device__ __forceinline__ float wave_sum(float v) {
#pragma unroll
    for (int o = 1; o < 64; o <<= 1) v += __shfl_xor(v, o);
    return v;
}
__device__ __forceinline__ void unpack8(const u32x4 w, float* f) {
    f[0] = bf2f(w.x & 0xffffu); f[1] = bf2f(w.x >> 16); f[2] = bf2f(w.y & 0xffffu); f[3] = bf2f(w.y >> 16);
    f[4] = bf2f(w.z & 0xffffu); f[5] = bf2f(w.z >> 16); f[6] = bf2f(w.w & 0xffffu); f[7] = bf2f(w.w >> 16);
}

namespace pg8 {
constexpr int BM = 256, BK = 64, HALF = 128, HTB = HALF * BK * 2, STAGE_BYTES = 8 * HTB, NXCD = 8, WGM = 8;
__host__ __device__ __forceinline__ int lds_byte(int r, int c) { const int st = (r >> 4) * 2 + (c >> 5), rr = r & 15, cc = c & 31, ob = rr * 64 + cc * 2; return st * 1024 + (ob ^ (((ob >> 9) & 1) << 5)); }
__host__ __device__ __forceinline__ void stage_rc(int b, int& R, int& C) { const int st = b / 1024, sb = b % 1024, swz = sb ^ (((sb >> 9) & 1) << 5); R = (st >> 1) * 16 + swz / 64; C = (st & 1) * 32 + (swz % 64) / 2; }
__host__ __device__ __forceinline__ int perm32(int rho) { const int n = rho >> 4, i = rho & 15; return 8 * (i >> 2) + 4 * n + (i & 3); }

struct Unit { const char* aP; const char* bP; size_t co; int ldc; int r0, c0; };
struct Gemm { int lda, ldb, K; };

template <class Map> struct Order {
    int n, G, c; Map map;
    __device__ __forceinline__ bool next(int i, Unit& u) const { const long L = (long)i * G + c; if (L >= n) return false; map((int)L, u); return true; }
};
struct MapGrid {
    const char* A; const char* B; int nM, nN; size_t ars, brs; int pm0, pn0;
    __device__ __forceinline__ void operator()(int L, Unit& u) const {
        const int nwg = nM * nN; int wgid = L;
        { const int q = nwg / NXCD, r = nwg % NXCD, xcd = wgid % NXCD, off = wgid / NXCD; wgid = (xcd < r ? xcd * (q + 1) : r * (q + 1) + (xcd - r) * q) + off; }
        const int nig = WGM * nN, gid = wgid / nig, fm = gid * WGM, gsz = (nM - fm) < WGM ? (nM - fm) : WGM;
        const int pm = pm0 + fm + ((wgid % nig) % gsz), pn = pn0 + (wgid % nig) / gsz;
        u.aP = A + (size_t)pm * ars; u.bP = B + (size_t)pn * brs; u.r0 = pm * BM; u.c0 = pn * BM; u.co = 0; u.ldc = 0;
    }
};

template <class Epi, class Sched>
__device__ __forceinline__ void gemm_phase(LAS unsigned char* lds, const Gemm g, const Sched& S, const Epi& E) {
    int tid_ = threadIdx.x; asm volatile("" : "+v"(tid_));
    const int tid = tid_, wid = __builtin_amdgcn_readfirstlane(tid >> 6), lane = tid & 63, wr = wid >> 2, wc = wid & 3, fr = lane & 15, fq = lane >> 4;
    const int K = g.K, nt = K / BK;
    unsigned voffA[2], voffB[2];
#pragma unroll
    for (int i = 0; i < 2; ++i) { int R, C; stage_rc(tid * 16 + i * 8192, R, C); const int Rb = Epi::CH64 ? (64 * (R >> 5) + perm32(R & 31)) : Epi::PERM ? ((R & ~31) + perm32(R & 31)) : R;
        voffA[i] = (unsigned)(R * g.lda + C) * 2u; voffB[i] = (unsigned)(Rb * g.ldb + C) * 2u; }
    const size_t kstep = (size_t)(BK * 2);
    const size_t hstepA = (size_t)HALF * g.lda * 2, hstepB = (size_t)(Epi::CH64 ? 32 : HALF) * g.ldb * 2;
    const unsigned ldsw = (unsigned)wid * 1024u;
    const int aoff = lds_byte(wr * 64 + fr, fq * 8), boff = lds_byte(wc * 32 + fr, fq * 8);
#define PG8_SA(b, h) (((b) * 2 + (h)) * HTB)
#define PG8_SB(b, h) ((4 + (b) * 2 + (h)) * HTB)
#define PG8_STAGE(bufoff, gbase, voff) do { const char* _gb = (const char*)(gbase); asm volatile("" : "+s"(_gb)); _Pragma("unroll") for (int _i = 0; _i < 2; ++_i) \
        __builtin_amdgcn_global_load_lds((const unsigned*)(_gb + (voff)[_i]), (LAS unsigned*)(lds + (bufoff) + ldsw + _i * 8192), 16, 0, 0); } while (0)
#define PG8_LDA(dst, b, h) do { _Pragma("unroll") for (int m = 0; m < 4; ++m) _Pragma("unroll") for (int k = 0; k < 2; ++k) dst[m][k] = *(const LAS bf16x8*)(lds + PG8_SA(b, h) + aoff + m * 2048 + k * 1024); } while (0)
#define PG8_LDB(dst, b, h) do { _Pragma("unroll") for (int n = 0; n < 2; ++n) _Pragma("unroll") for (int k = 0; k < 2; ++k) dst[n][k] = *(const LAS bf16x8*)(lds + PG8_SB(b, h) + boff + n * 2048 + k * 1024); } while (0)
#define PG8_MMA(ai, bj, At, Bt) do { __builtin_amdgcn_s_setprio(1); _Pragma("unroll") for (int m = 0; m < 4; ++m) _Pragma("unroll") for (int n = 0; n < 2; ++n) _Pragma("unroll") for (int k = 0; k < 2; ++k) \
        acc[ai][bj][m][n] = __builtin_amdgcn_mfma_f32_16x16x32_bf16(Bt[n][k], At[m][k], acc[ai][bj][m][n], 0, 0, 0); __builtin_amdgcn_s_setprio(0); } while (0)
#define PG8_WAIT_V(n) asm volatile("s_waitcnt vmcnt(" #n ")" ::: "memory")
#define PG8_WAIT_L(n) asm volatile("s_waitcnt lgkmcnt(" #n ")" ::: "memory")
#define PG8_BAR __builtin_amdgcn_s_barrier()
#define PG8_SCHED __builtin_amdgcn_sched_barrier(0)
    Unit cur, nxt; int ui = 0;
    if (!S.next(0, cur)) return;
    f32x4 acc[2][2][4][2];
#pragma unroll
    for (int a = 0; a < 2; ++a)
#pragma unroll
        for (int b = 0; b < 2; ++b)
#pragma unroll
            for (int m = 0; m < 4; ++m)
#pragma unroll
                for (int n = 0; n < 2; ++n) acc[a][b][m][n] = (f32x4){0.f, 0.f, 0.f, 0.f};
    bf16x8 At[4][2], B0[2][2], B1[2][2];
    const char* cA = cur.aP; const char* cB = cur.bP;
    PG8_STAGE(PG8_SB(0, 0), cB, voffB); PG8_STAGE(PG8_SB(0, 1), cB + hstepB, voffB); PG8_STAGE(PG8_SA(0, 0), cA, voffA); PG8_STAGE(PG8_SA(0, 1), cA + hstepA, voffA);
    if (wr == 1) PG8_BAR;
    PG8_WAIT_V(2); PG8_BAR;
    PG8_STAGE(PG8_SB(1, 0), cB + kstep, voffB); PG8_STAGE(PG8_SA(1, 0), cA + kstep, voffA); PG8_STAGE(PG8_SB(1, 1), cB + hstepB + kstep, voffB);
    PG8_WAIT_V(6); PG8_BAR;
    for (;;) {
        const bool has_next = S.next(ui + 1, nxt);
        const char* nA = has_next ? nxt.aP : cA; const char* nB = has_next ? nxt.bP : cB;
#pragma unroll 1
        for (int t = 0; t < nt; t += 2) {
            const bool last = (t == nt - 2);
            const char* a1 = cA + (size_t)(t + 1) * kstep;
            const char* a2 = last ? nA : cA + (size_t)(t + 2) * kstep; const char* b2 = last ? nB : cB + (size_t)(t + 2) * kstep;
            const char* a3 = a2 + kstep; const char* b3 = b2 + kstep;
            if constexpr (Epi::HAS_MID) { if (t == (nt >> 1)) E.mid(acc, cur, wr, wc, fr, fq); }
            PG8_LDB(B0, 0, 0); PG8_LDB(B1, 0, 1); PG8_SCHED; PG8_LDA(At, 0, 0); PG8_STAGE(PG8_SA(1, 1), a1 + hstepA, voffA);
            PG8_WAIT_V(8); PG8_WAIT_L(0); PG8_BAR; PG8_MMA(0, 0, At, B0); PG8_MMA(0, 1, At, B1); PG8_BAR; PG8_SCHED;
            PG8_LDA(At, 0, 1); PG8_STAGE(PG8_SB(0, 0), b2, voffB); PG8_STAGE(PG8_SB(0, 1), b2 + hstepB, voffB); PG8_STAGE(PG8_SA(0, 0), a2, voffA);
            PG8_WAIT_V(8); PG8_WAIT_L(0); PG8_BAR; PG8_MMA(1, 0, At, B0); PG8_MMA(1, 1, At, B1); PG8_BAR; PG8_SCHED;
            PG8_LDB(B0, 1, 0); PG8_LDB(B1, 1, 1); PG8_SCHED; PG8_LDA(At, 1, 0); PG8_STAGE(PG8_SA(0, 1), a2 + hstepA, voffA);
            PG8_WAIT_V(8); PG8_WAIT_L(0); PG8_BAR; PG8_MMA(0, 0, At, B0); PG8_MMA(0, 1, At, B1); PG8_BAR; PG8_SCHED;
            PG8_LDA(At, 1, 1); PG8_STAGE(PG8_SB(1, 0), b3, voffB); PG8_STAGE(PG8_SB(1, 1), b3 + hstepB, voffB); PG8_STAGE(PG8_SA(1, 0), a3, voffA);
            PG8_WAIT_V(8); PG8_WAIT_L(0); PG8_BAR; PG8_MMA(1, 0, At, B0); PG8_MMA(1, 1, At, B1); PG8_BAR; PG8_SCHED;
        }
        if (wr == 0) PG8_BAR;
        E(acc, cur, wr, wc, fr, fq);
        if constexpr (Epi::PROBE2) E(acc, cur, wr, wc, fr, fq);
        if (!has_next) break;
#pragma unroll
        for (int a = 0; a < 2; ++a)
#pragma unroll
            for (int b = 0; b < 2; ++b)
#pragma unroll
                for (int m = 0; m < 4; ++m)
#pragma unroll
                    for (int n = 0; n < 2; ++n) acc[a][b][m][n] = (f32x4){0.f, 0.f, 0.f, 0.f};
        cur = nxt; cA = nA; cB = nB; ++ui;
        if (wr == 1) PG8_BAR;
    }
    PG8_WAIT_V(0);
    PG8_BAR;
#undef PG8_SA
#undef PG8_SB
#undef PG8_STAGE
#undef PG8_LDA
#undef PG8_LDB
#undef PG8_MMA
#undef PG8_WAIT_V
#undef PG8_WAIT_L
#undef PG8_BAR
#undef PG8_SCHED
}
}
using pg8::Unit;


struct EpiIn {
    static constexpr bool PERM = true, HAS_MID = false, PROBE2 = false, CH64 = true;
    bf16_t* P; bf16_t* QN; bf16_t* KC; float* ock; const float* gq; const float* gk; const float* RT; int l; unsigned char* GN; unsigned char* ZN;
    __device__ __forceinline__ void operator()(const f32x4 (&acc)[2][2][4][2], const Unit& u, int wr, int wc, int fr, int fq) const {
        const int pn = u.c0 >> 8;
        const int row0 = u.r0 + wr * 64 + fr;
        if (pn >= 8 && pn < 16) {
            const bool isq = pn < 12, smp = u.r0 >= NPROMPT;
            const int hc = ((u.c0 - (isq ? C_Q : C_K)) >> 6) + wc;
            const float* gp = (isq ? gq : gk) + 8 * fq;
            const f32x4 g00 = *(const f32x4*)gp, g01 = *(const f32x4*)(gp + 4), g10 = *(const f32x4*)(gp + 32), g11 = *(const f32x4*)(gp + 36);
            const bool isx2 = fq >= 2; const int jb = 8 * (fq & 1);
#pragma unroll
            for (int ai = 0; ai < 2; ++ai)
#pragma unroll
                for (int m = 0; m < 4; ++m) { int rowi = row0 + ai * 128 + m * 16; asm volatile("" : "+v"(rowi) :: "memory");
                    f32x4 y[2][2] = {{acc[ai][0][m][0], acc[ai][0][m][1]}, {acc[ai][1][m][0], acc[ai][1][m][1]}};
                    float ss = 0.f;
#pragma unroll
                    for (int a_ = 0; a_ < 2; ++a_)
#pragma unroll
                        for (int b_ = 0; b_ < 2; ++b_) ss += (y[a_][b_][0] * y[a_][b_][0] + y[a_][b_][1] * y[a_][b_][1]) + (y[a_][b_][2] * y[a_][b_][2] + y[a_][b_][3] * y[a_][b_][3]);
                    ss += __shfl_xor(ss, 16); ss += __shfl_xor(ss, 32);
                    const float rs = 1.0f / sqrtf(ss * (1.0f / 64.0f) + EPS);
                    y[0][0] = y[0][0] * rs * g00; y[0][1] = y[0][1] * rs * g01; y[1][0] = y[1][0] * rs * g10; y[1][1] = y[1][1] * rs * g11;
                    int b, n, Nq, Nk, koff; size_t base;
                    if (!smp) { b = rowi >> 8; n = rowi & 255; Nq = PSEQ; Nk = PSEQ; koff = 0; base = 0; }
                    else { const int r2 = rowi - NPROMPT; b = r2 >> 12; n = r2 & 4095; Nq = SSEQ; Nk = SNK; koff = PAST; base = (size_t)PB * 16 * PSEQ * 64; }
                    if (smp) {
                        const float* tr = RT + (n >> 6) * 16 + jb; const float* tc = RT + (n & 63) * 16 + jb;
#pragma unroll
                        for (int a_ = 0; a_ < 2; ++a_) { const float* tp = a_ ? tc : tr;
#pragma unroll
                            for (int b_ = 0; b_ < 2; ++b_) { const f32x4 c4 = *(const f32x4*)(tp + 4 * b_), s4 = *(const f32x4*)(tp + 1024 + 4 * b_);
#pragma unroll
                                for (int j = 0; j < 4; ++j) { const float pr = __shfl_xor(y[a_][b_][j], 32); y[a_][b_][j] = isx2 ? (y[a_][b_][j] * c4[j] + pr * s4[j]) : (y[a_][b_][j] * c4[j] - pr * s4[j]); } } }
                    }
                    if (isq) { bf16_t* dst = QN + base + ((size_t)(b * 16 + hc) * Nq + n) * 64 + 8 * fq;
#pragma unroll
                        for (int a_ = 0; a_ < 2; ++a_) { const f32x4 v0 = y[a_][0] * QSCALE, v1 = y[a_][1] * QSCALE;
                            u32x4 w; w.x = cvtpk(v0[0], v0[1]); w.y = cvtpk(v0[2], v0[3]); w.z = cvtpk(v1[0], v1[1]); w.w = cvtpk(v1[2], v1[3]); *(u32x4*)(dst + 32 * a_) = w; } }
                    else { bf16_t* dst = KC + base + ((size_t)(b * 16 + hc) * Nk + koff + n) * 64 + 8 * fq;
#pragma unroll
                        for (int a_ = 0; a_ < 2; ++a_) { const f32x4 v0 = y[a_][0], v1 = y[a_][1];
                            u32x4 w; w.x = cvtpk(v0[0], v0[1]); w.y = cvtpk(v0[2], v0[3]); w.z = cvtpk(v1[0], v1[1]); w.w = cvtpk(v1[2], v1[3]); *(u32x4*)(dst + 32 * a_) = w; }
                        if (!smp) { float* o = ock + ((size_t)(b * DEPTH + l) * PSEQ + n) * 1024 + hc * 64 + 8 * fq;
#pragma unroll
                            for (int a_ = 0; a_ < 2; ++a_) { *(f32x4*)(o + 32 * a_) = y[a_][0]; *(f32x4*)(o + 32 * a_ + 4) = y[a_][1]; } } }
                    asm volatile("" ::: "memory"); }
            return;
        }
        const int mode = (pn < 4) ? 0 : (pn < 8) ? 1 : (pn < 20) ? 0 : (pn < 24) ? 1 : 2;
        const int col0 = u.c0 + wc * 64 + 8 * fq;
        const bool native = (pn >= 4 && pn < 8) || pn >= 24;
        unsigned char* nbase = (pn >= 24) ? GN + nat_off((u.r0 >> 8) * 16 + (pn - 24), 0, 0, 0, wr * 4 + wc, 0) : ZN + nat_off((u.r0 >> 8) * 4 + (pn - 4), 0, 0, 0, wr * 4 + wc, 0);
#pragma unroll
        for (int ai = 0; ai < 2; ++ai)
#pragma unroll
            for (int m = 0; m < 4; ++m) { int rowi = row0 + ai * 128 + m * 16; asm volatile("" : "+v"(rowi) :: "memory"); bf16_t* rowp = P + (size_t)rowi * INC + col0;
#pragma unroll
                for (int bj = 0; bj < 2; ++bj) { f32x4 v0 = acc[ai][bj][m][0], v1 = acc[ai][bj][m][1];
                    if (mode == 1) {
#pragma unroll
                        for (int j = 0; j < 4; ++j) { v0[j] = siluf_(v0[j]); v1[j] = siluf_(v1[j]); } }
                    else if (mode == 2) {
#pragma unroll
                        for (int j = 0; j < 4; ++j) { v0[j] = sigmoidf_(v0[j]); v1[j] = sigmoidf_(v1[j]); } }
                    u32x4 w; w.x = cvtpk(v0[0], v0[1]); w.y = cvtpk(v0[2], v0[3]); w.z = cvtpk(v1[0], v1[1]); w.w = cvtpk(v1[2], v1[3]);
                    if (native) { unsigned vo = (unsigned)(fr + 16 * fq) * 16u; asm volatile("" : "+v"(vo)); __builtin_nontemporal_store(w, (u32x4*)(nbase + (size_t)((ai * 4 + m) * 2 + bj) * 8192 + vo)); } else __builtin_nontemporal_store(w, (u32x4*)(rowp + bj * 32)); }
                asm volatile("" ::: "memory"); }
    }
};
struct EpiStore {
    static constexpr bool PERM = true, HAS_MID = false, PROBE2 = false, CH64 = false;
    bf16_t* O;
    __device__ __forceinline__ void operator()(const f32x4 (&acc)[2][2][4][2], const Unit& u, int wr, int wc, int fr, int fq) const {
        bf16_t* base = O + u.co + (size_t)(wr * 64 + fr) * u.ldc + wc * 32 + 8 * fq;
#pragma unroll
        for (int ai = 0; ai < 2; ++ai)
#pragma unroll
            for (int m = 0; m < 4; ++m) { int rowi = ai * 128 + m * 16; asm volatile("" : "+v"(rowi) :: "memory"); bf16_t* rowp = base + (size_t)rowi * u.ldc;
#pragma unroll
                for (int bj = 0; bj < 2; ++bj) { const f32x4 v0 = acc[ai][bj][m][0], v1 = acc[ai][bj][m][1];
                    u32x4 w; w.x = cvtpk(v0[0], v0[1]); w.y = cvtpk(v0[2], v0[3]); w.z = cvtpk(v1[0], v1[1]); w.w = cvtpk(v1[2], v1[3]);
                    *(u32x4*)(rowp + bj * 128) = w; }
                asm volatile("" ::: "memory"); }
    }
};
struct EpiPos {
    static constexpr bool PERM = true, HAS_MID = false, PROBE2 = false, CH64 = true;
    const unsigned char* ZN; bf16_t* Y;
    __device__ __forceinline__ void operator()(const f32x4 (&acc)[2][2][4][2], const Unit& u, int wr, int wc, int fr, int fq) const {
        const int row0 = u.r0 + wr * 64 + fr, col0 = u.c0 + wc * 64 + 8 * fq;
        const unsigned char* nb = ZN + nat_off((u.r0 >> 8) * 4 + (u.c0 >> 8), 0, 0, 0, wr * 4 + wc, 0);
#pragma unroll
        for (int ai = 0; ai < 2; ++ai)
#pragma unroll
            for (int m = 0; m < 4; ++m) { int rowi = row0 + ai * 128 + m * 16; asm volatile("" : "+v"(rowi) :: "memory"); const size_t row = (size_t)rowi;
#pragma unroll
                for (int bj = 0; bj < 2; ++bj) { const f32x4 v0 = acc[ai][bj][m][0], v1 = acc[ai][bj][m][1];
                    unsigned vo = (unsigned)(fr + 16 * fq) * 16u; asm volatile("" : "+v"(vo)); const u32x4 z = *(const u32x4*)(nb + (size_t)((ai * 4 + m) * 2 + bj) * 8192 + vo); float zf[8]; unpack8(z, zf);
                    u32x4 w; w.x = cvtpk(v0[0] * zf[0], v0[1] * zf[1]); w.y = cvtpk(v0[2] * zf[2], v0[3] * zf[3]); w.z = cvtpk(v1[0] * zf[4], v1[1] * zf[5]); w.w = cvtpk(v1[2] * zf[6], v1[3] * zf[7]);
                    *(u32x4*)(Y + row * D + col0 + bj * 32) = w; }
                asm volatile("" ::: "memory"); }
    }
};
struct EpiMerge {
    static constexpr bool PERM = true, HAS_MID = true, PROBE2 = false, CH64 = true;
    const unsigned char* GN; bf16_t* MG;
    __device__ __forceinline__ void mid(f32x4 (&acc)[2][2][4][2], const Unit& u, int wr, int wc, int fr, int fq) const {
        const unsigned char* gfb = GN + nat_off((u.r0 >> 8) * 16 + (u.c0 >> 8), 0, 0, 0, wr * 4 + wc, 0); const unsigned char* gab = gfb + (size_t)8 * 131072;
#pragma unroll
        for (int ai = 0; ai < 2; ++ai) {
            unsigned vo = (unsigned)(fr + 16 * fq) * 16u; asm volatile("" : "+v"(vo) :: "memory");
            u32x4 ra[4][2], rb[4][2];
#pragma unroll
            for (int m = 0; m < 4; ++m)
#pragma unroll
                for (int bj = 0; bj < 2; ++bj) { const size_t o = (size_t)((ai * 4 + m) * 2 + bj) * 8192; ra[m][bj] = *(const u32x4*)(gfb + o + vo); rb[m][bj] = *(const u32x4*)(gab + o + vo); }
            __builtin_amdgcn_sched_barrier(0);
#pragma unroll
            for (int m = 0; m < 4; ++m)
#pragma unroll
                for (int bj = 0; bj < 2; ++bj) { float gf[8], ga[8]; unpack8(ra[m][bj], gf); unpack8(rb[m][bj], ga);
#pragma unroll
                    for (int j = 0; j < 4; ++j) { acc[ai][bj][m][0][j] *= gf[j] * __builtin_amdgcn_rcpf(ga[j]); acc[ai][bj][m][1][j] *= gf[4 + j] * __builtin_amdgcn_rcpf(ga[4 + j]); } }
            asm volatile("" ::: "memory"); }
    }
    __device__ __forceinline__ void operator()(const f32x4 (&acc)[2][2][4][2], const Unit& u, int wr, int wc, int fr, int fq) const {
        const int row0 = u.r0 + wr * 64 + fr, col0 = u.c0 + wc * 64 + 8 * fq;
        const unsigned char* gab = GN + nat_off((u.r0 >> 8) * 16 + 8 + (u.c0 >> 8), 0, 0, 0, wr * 4 + wc, 0);
#pragma unroll
        for (int ai = 0; ai < 2; ++ai)
#pragma unroll
            for (int m = 0; m < 4; ++m) { int rowi = row0 + ai * 128 + m * 16; asm volatile("" : "+v"(rowi) :: "memory"); const size_t row = (size_t)rowi;
#pragma unroll
                for (int bj = 0; bj < 2; ++bj) { const f32x4 v0 = acc[ai][bj][m][0], v1 = acc[ai][bj][m][1];
                    unsigned vo = (unsigned)(fr + 16 * fq) * 16u; asm volatile("" : "+v"(vo)); const u32x4 b = *(const u32x4*)(gab + (size_t)((ai * 4 + m) * 2 + bj) * 8192 + vo); float ga[8]; unpack8(b, ga);
                    u32x4 w; w.x = cvtpk(v0[0] * ga[0], v0[1] * ga[1]); w.y = cvtpk(v0[2] * ga[2], v0[3] * ga[3]); w.z = cvtpk(v1[0] * ga[4], v1[1] * ga[5]); w.w = cvtpk(v1[2] * ga[6], v1[3] * ga[7]);
                    *(u32x4*)(MG + row * D + col0 + bj * 32) = w; }
                asm volatile("" ::: "memory"); }
    }
};
struct EpiOut {
    static constexpr bool PERM = false, HAS_MID = false, PROBE2 = false, CH64 = false;
    const float* xp; const float* xs; float* out; const float* mod;
    __device__ __forceinline__ void operator()(const f32x4 (&acc)[2][2][4][2], const Unit& u, int wr, int wc, int fr, int fq) const {
        const int row0 = u.r0 + wr * 64 + fr, col0 = u.c0 + wc * 32 + 4 * fq;
        const int cv = (u.r0 < NPROMPT) ? 0 : 1 + ((u.r0 - NPROMPT) >> 12);
        const float* gate = mod + cv * 6144 + 4096 + col0;
        const float* xin = (u.r0 < NPROMPT) ? xp : xs - (size_t)NPROMPT * D;
        f32x4 gv[2][2];
#pragma unroll
        for (int bj = 0; bj < 2; ++bj)
#pragma unroll
            for (int n = 0; n < 2; ++n) gv[bj][n] = *(const f32x4*)(gate + bj * 128 + n * 16);
        f32x4 xn[2][2];
        { int rowi = row0; asm volatile("" : "+v"(rowi) :: "memory"); const size_t off = (size_t)rowi * D + col0;
#pragma unroll
          for (int bj = 0; bj < 2; ++bj)
#pragma unroll
              for (int n = 0; n < 2; ++n) xn[bj][n] = *(const f32x4*)(xin + off + bj * 128 + n * 16); }
#pragma unroll
        for (int g = 0; g < 8; ++g) { const int ai = g >> 2, m = g & 3;
            f32x4 xo[2][2];
#pragma unroll
            for (int bj = 0; bj < 2; ++bj)
#pragma unroll
                for (int n = 0; n < 2; ++n) xo[bj][n] = xn[bj][n];
            if (g < 7) { int rowi = row0 + ((g + 1) >> 2) * 128 + ((g + 1) & 3) * 16; asm volatile("" : "+v"(rowi)); const size_t off = (size_t)rowi * D + col0;
#pragma unroll
                for (int bj = 0; bj < 2; ++bj)
#pragma unroll
                    for (int n = 0; n < 2; ++n) xn[bj][n] = *(const f32x4*)(xin + off + bj * 128 + n * 16); }
            __builtin_amdgcn_sched_barrier(0);
            { int rowi = row0 + ai * 128 + m * 16; asm volatile("" : "+v"(rowi)); const size_t off = (size_t)rowi * D + col0;
#pragma unroll
              for (int bj = 0; bj < 2; ++bj)
#pragma unroll
                  for (int n = 0; n < 2; ++n) *(f32x4*)(out + off + bj * 128 + n * 16) = xo[bj][n] + gv[bj][n] * acc[ai][bj][m][n]; }
            __builtin_amdgcn_sched_barrier(0); }
        asm volatile("" ::: "memory");
    }
};

struct MapChan {
    const char* CST; const char* P;
    __device__ __forceinline__ void operator()(int L, Unit& u) const {
        int b, g, pm, pn, N1, tok0; size_t abt;
        if (L < 128) { b = L >> 3; g = (L >> 1) & 3; pm = L & 1; pn = 0; N1 = PSEQ; tok0 = b * PSEQ; abt = (size_t)b * 1024 * 512; }
        else { const int M_ = L - 128; b = M_ >> 7; g = (M_ >> 5) & 3; pm = (M_ >> 4) & 1; pn = M_ & 15; N1 = SSEQ; tok0 = NPROMPT + b * SSEQ; abt = (size_t)PB * 1024 * 512 + (size_t)b * 1024 * 8192; }
        u.aP = CST + (size_t)pm * 256 * 256 * 2;
        u.bP = P + ((size_t)(tok0 + pn * 256) * INC + C_UF + g * 256) * 2;
        u.co = abt + (size_t)(g * 256) * (2 * N1) + (size_t)pm * N1 + pn * 256; u.ldc = 2 * N1; u.r0 = 0; u.c0 = 0;
    }
};
struct MapPosP {
    const char* T; const char* ABT;
    __device__ __forceinline__ void operator()(int L, Unit& u) const {
        const int b = L >> 2, pn = L & 3;
        u.aP = T; u.bP = ABT + ((size_t)b * 1024 * 512 + (size_t)pn * 256 * 512) * 2; u.r0 = b * PSEQ; u.c0 = pn * 256; u.co = 0; u.ldc = 0;
    }
};
struct MapPosS {
    const char* T; const char* FB;
    __device__ __forceinline__ void operator()(int L, Unit& u) const {
        const int b = L >> 6, pm = (L >> 2) & 15, pn = L & 3;
        u.aP = T + (size_t)pm * 256 * 4096 * 2; u.bP = FB + ((size_t)b * 1024 * 4096 + (size_t)pn * 256 * 4096) * 2;
        u.r0 = NPROMPT + b * SSEQ + pm * 256; u.c0 = pn * 256; u.co = 0; u.ldc = 0;
    }
};

struct Args {
    const float* in[20]; float* out; unsigned char* ws; int ph_lo, ph_hi;
};

__device__ __forceinline__ void transpose_item(const float* W, int N, bf16_t* WT, int ldwt, int koff, LAS float* scr, int item, int lane) {
    const int nblk = N / 32, kb = item / nblk, nb = item % nblk, k0 = 64 * kb, n0 = 32 * nb;
#pragma unroll 8
    for (int i = 0; i < 32; ++i) { const int kk = 2 * i + (lane >> 5); scr[kk * 33 + (lane & 31)] = W[(size_t)(k0 + kk) * N + n0 + (lane & 31)]; }
    asm volatile("s_waitcnt lgkmcnt(0)" ::: "memory");
    const int c = lane & 7;
#pragma unroll
    for (int j = 0; j < 4; ++j) { const int n = (lane >> 3) + 8 * j; const LAS float* s = scr + (8 * c) * 33 + n;
        u32x4 o; o.x = cvtpk(s[0 * 33], s[1 * 33]); o.y = cvtpk(s[2 * 33], s[3 * 33]); o.z = cvtpk(s[4 * 33], s[5 * 33]); o.w = cvtpk(s[6 * 33], s[7 * 33]);
        *(u32x4*)(WT + (size_t)(n0 + n) * ldwt + koff + k0 + 8 * c) = o; }
    asm volatile("s_waitcnt lgkmcnt(0)" ::: "memory");
}

__device__ __forceinline__ void phase_pre0(const Args& a, LAS unsigned char* lds) {
    const int tid = threadIdx.x, lane = tid & 63, wave = __builtin_amdgcn_readfirstlane(tid >> 6), G = gridDim.x;
    unsigned char* ws = a.ws;
    {
        LAS float* scr = (LAS float*)(lds + wave * 16384);
        const int gw = blockIdx.x * 8 + wave, NGW = G * 8;
        constexpr int I_IN = 4 * 32 * 320, I_F = 4 * 16 * 64, I_O = 4 * 32 * 64, NIT = I_IN + 2 * I_F + I_O;
        bf16_t* WIN = (bf16_t*)(ws + WS_WIN); bf16_t* WM = (bf16_t*)(ws + WS_WM); bf16_t* WO = (bf16_t*)(ws + WS_WO);
        for (int it = gw; it < NIT; it += NGW) {
            int r = it;
            if (r < I_IN) { const int l = r / 10240, rr = r % 10240; transpose_item(a.in[6] + (size_t)l * D * INC, INC, WIN + (size_t)l * INC * D, D, 0, scr, rr, lane); continue; } r -= I_IN;
            if (r < I_F) { const int l = r / 1024, rr = r % 1024; transpose_item(a.in[7] + (size_t)l * 1024 * D, D, WM + (size_t)l * D * D, D, 0, scr, rr, lane); continue; } r -= I_F;
            if (r < I_F) { const int l = r / 1024, rr = r % 1024; transpose_item(a.in[8] + (size_t)l * 1024 * D, D, WM + (size_t)l * D * D, D, 1024, scr, rr, lane); continue; } r -= I_F;
            { const int l = r / 2048, rr = r % 2048; transpose_item(a.in[9] + (size_t)l * D * D, D, WO + (size_t)l * D * D, D, 0, scr, rr, lane); }
        }
    }
    __syncthreads();
    {
        LAS float* sc = (LAS float*)lds;
        float* MODP = (float*)(ws + WS_MODP);
        const float* wmod = a.in[10];
        for (int un = blockIdx.x; un < 768; un += G) {
            const int l = un / 192, part = (un / 12) % 16, jb = un % 12, j = jb * 512 + tid;
            __syncthreads();
            for (int idx = tid; idx < 640; idx += 512) { const int c = idx >> 7, i = idx & 127;
                const float v = (c == 0) ? a.in[5][part * 128 + i] : a.in[2][(c - 1) * D + part * 128 + i]; sc[idx] = siluf_(v); }
            __syncthreads();
            float s0 = 0.f, s1 = 0.f, s2 = 0.f, s3 = 0.f, s4 = 0.f;
            const float* wp = wmod + ((size_t)l * D + part * 128) * 6144 + j;
#pragma unroll 8
            for (int i = 0; i < 128; ++i) { const float w = wp[(size_t)i * 6144]; s0 += sc[i] * w; s1 += sc[128 + i] * w; s2 += sc[256 + i] * w; s3 += sc[384 + i] * w; s4 += sc[512 + i] * w; }
            float* o = MODP + ((size_t)(l * 16 + part) * 5) * 6144 + j;
            o[0] = s0; o[6144] = s1; o[2 * 6144] = s2; o[3 * 6144] = s3; o[4 * 6144] = s4;
        }
    }
    {
        const size_t gt = (size_t)blockIdx.x * 512 + tid, NT_ = (size_t)G * 512;
        bf16_t* T4 = (bf16_t*)(ws + WS_T4096); bf16_t* T2 = (bf16_t*)(ws + WS_TAB); bf16_t* CS = (bf16_t*)(ws + WS_TAB + 256 * 1024);
        for (size_t ch = gt; ch < (size_t)4096 * 512; ch += NT_) {
            const int k1 = (int)(ch >> 9), kk0 = (int)(ch & 511) * 8; float v[8];
#pragma unroll
            for (int e = 0; e < 8; ++e) { const int kk = kk0 + e, n1 = (kk <= 2048) ? kk : kk - 2048; const float fr_ = (float)((k1 * n1) & 4095) * (1.0f / 4096.0f);
                v[e] = (kk <= 2048) ? __builtin_amdgcn_cosf(fr_) * (1.0f / 64.0f) : -__builtin_amdgcn_sinf(fr_) * (1.0f / 64.0f); }
            u32x4 o; o.x = cvtpk(v[0], v[1]); o.y = cvtpk(v[2], v[3]); o.z = cvtpk(v[4], v[5]); o.w = cvtpk(v[6], v[7]);
            *(u32x4*)(T4 + ch * 8) = o;
        }
        for (size_t ch = gt; ch < (size_t)256 * 64; ch += NT_) {
            const int k1 = (int)(ch >> 6), kk0 = (int)(ch & 63) * 8; float v[8];
#pragma unroll
            for (int e = 0; e < 8; ++e) { const int kk = kk0 + e, n1 = kk & 255; const float fr_ = (float)((k1 * n1) & 255) * (1.0f / 256.0f);
                v[e] = (kk < 256) ? __builtin_amdgcn_cosf(fr_) * (1.0f / 16.0f) : -__builtin_amdgcn_sinf(fr_) * (1.0f / 16.0f); }
            u32x4 o; o.x = cvtpk(v[0], v[1]); o.y = cvtpk(v[2], v[3]); o.z = cvtpk(v[4], v[5]); o.w = cvtpk(v[6], v[7]);
            *(u32x4*)(T2 + ch * 8) = o;
        }
        for (size_t ch = gt; ch < (size_t)512 * 32; ch += NT_) {
            const int m = (int)(ch >> 5), c0 = (int)(ch & 31) * 8, k2 = m & 255; float v[8];
#pragma unroll
            for (int e = 0; e < 8; ++e) { const float fr_ = (float)((k2 * (c0 + e)) & 255) * (1.0f / 256.0f);
                v[e] = (m < 256) ? __builtin_amdgcn_cosf(fr_) * (1.0f / 16.0f) : __builtin_amdgcn_sinf(fr_) * (1.0f / 16.0f); }
            u32x4 o; o.x = cvtpk(v[0], v[1]); o.y = cvtpk(v[2], v[3]); o.z = cvtpk(v[4], v[5]); o.w = cvtpk(v[6], v[7]);
            *(u32x4*)(CS + ch * 8) = o;
        }
        float* RT = (float*)(ws + WS_TAB + 512 * 1024);
        if (gt < 1024) { const int pos = (int)(gt >> 4), j = (int)(gt & 15); float sn_, cs_; sincosf((float)pos * exp2f(-(float)j * (13.287712379549449f / 16.0f)), &sn_, &cs_); RT[gt] = cs_; RT[1024 + gt] = sn_; }
    }
}
__device__ __forceinline__ void phase_pre1(const Args& a) {
    const size_t gt = (size_t)blockIdx.x * 512 + threadIdx.x, NT_ = (size_t)gridDim.x * 512;
    const float* MODP = (const float*)(a.ws + WS_MODP); float* MOD = (float*)(a.ws + WS_MOD);
    for (size_t idx = gt; idx < (size_t)4 * 5 * 6144; idx += NT_) {
        const int l = (int)(idx / 30720), c = (int)((idx / 6144) % 5), j = (int)(idx % 6144);
        float s = a.in[11][l * 6144 + j];
#pragma unroll
        for (int p = 0; p < 16; ++p) s += MODP[((size_t)(l * 16 + p) * 5 + c) * 6144 + j];
        MOD[idx] = s;
    }
    if (gt < 4) { const int l = (int)gt; float s1 = 0.f, s2 = 0.f;
        for (int i = 0; i < 64; ++i) { s1 += a.in[16][l * 64 + i] * a.in[17][l * 64 + i]; s2 += a.in[18][l * 64 + i] * a.in[19][l * 64 + i]; }
        const float lam_init = 0.8f - 0.6f * expf(-0.3f * (float)l);
        MOD[4 * 5 * 6144 + l] = expf(s1) - expf(s2) + lam_init; }
}
__device__ __forceinline__ void phase_norm(const Args& a, int l) {
    int tid_ = threadIdx.x; asm volatile("" : "+v"(tid_));
    const int tid = tid_, lane = tid & 63, wave = tid >> 6, G = gridDim.x;
    const int gw = blockIdx.x * 8 + wave, NGW = G * 8;
    const float* MOD = (const float*)(a.ws + WS_MOD) + (size_t)l * 5 * 6144;
    const float* gn = a.in[12] + l * D;
    bf16_t* H = (bf16_t*)(a.ws + WS_H);
    for (int row = gw; row < NTOK; row += NGW) {
        const float* xrow = (l == 0) ? ((row < NPROMPT) ? a.in[0] + (size_t)row * D : a.in[1] + (size_t)(row - NPROMPT) * D) : a.out + (size_t)row * D;
        const int cv = (row < NPROMPT) ? 0 : 1 + ((row - NPROMPT) >> 12);
        const f32x4* xr = (const f32x4*)xrow + lane;
        f32x4 v[8]; float ss = 0.f;
#pragma unroll
        for (int j = 0; j < 8; ++j) { v[j] = xr[64 * j]; ss += (v[j].x * v[j].x + v[j].y * v[j].y) + (v[j].z * v[j].z + v[j].w * v[j].w); }
        const float rstd = 1.0f / sqrtf(wave_sum(ss) * (1.0f / D) + EPS);
        const float* sh = MOD + cv * 6144; const float* sc = sh + 2048;
#pragma unroll
        for (int j = 0; j < 8; ++j) { const int idx = (lane + 64 * j) * 4;
            const f32x4 g4 = *(const f32x4*)(gn + idx), s4 = *(const f32x4*)(sc + idx), h4 = *(const f32x4*)(sh + idx);
            const f32x4 o = v[j] * rstd * g4 * (s4 + 1.0f) + h4;
            u32x2 w; w.x = cvtpk(o.x, o.y); w.y = cvtpk(o.z, o.w);
            *(u32x2*)(H + (size_t)row * D + idx) = w; }
    }
    const size_t gt = (size_t)blockIdx.x * 512 + tid, NT_ = (size_t)G * 512;
    bf16_t* KCs = (bf16_t*)(a.ws + WS_KC) + (size_t)PB * 8 * 2 * PSEQ * 64;
    bf16_t* VTs = (bf16_t*)(a.ws + WS_VT) + (size_t)PB * 8 * 128 * PSEQ;
    for (size_t ch = gt; ch < (size_t)SB * PAST * 128; ch += NT_) {
        const int c8 = (int)(ch & 7), hc = (int)((ch >> 3) & 15), key = (int)((ch >> 7) & 511), b = (int)(ch >> 16);
        const float* src = a.in[3] + (((size_t)(b * DEPTH + l) * PAST + key) * 1024 + hc * 64 + c8 * 8);
        const f32x4 x0 = *(const f32x4*)src, x1 = *(const f32x4*)(src + 4);
        u32x4 w; w.x = cvtpk(x0.x, x0.y); w.y = cvtpk(x0.z, x0.w); w.z = cvtpk(x1.x, x1.y); w.w = cvtpk(x1.z, x1.w);
        *(u32x4*)(KCs + (((size_t)(b * 16 + hc)) * SNK + key) * 64 + c8 * 8) = w;
    }
    for (size_t ch = gt; ch < (size_t)SB * 8 * 64 * 32; ch += NT_) {
        const int d4 = (int)(ch & 31) * 4, pc = (int)((ch >> 5) & 63), h = (int)((ch >> 11) & 7), b = (int)(ch >> 14);
        const int s_ = pc >> 1, hf = pc & 1; f32x4 x[8];
#pragma unroll
        for (int i = 0; i < 8; ++i) { const int key = 16 * s_ + 8 * (i >> 2) + 4 * hf + (i & 3);
            x[i] = *(const f32x4*)(a.in[4] + ((size_t)(b * DEPTH + l) * PAST + key) * 1024 + h * 128 + d4); }
#pragma unroll
        for (int j = 0; j < 4; ++j) { u32x4 w; w.x = cvtpk(x[0][j], x[1][j]); w.y = cvtpk(x[2][j], x[3][j]); w.z = cvtpk(x[4][j], x[5][j]); w.w = cvtpk(x[6][j], x[7][j]);
            *(u32x4*)(VTs + ((size_t)(b * 8 + h) * 128 + d4 + j) * SNK + pc * 8) = w; }
    }
}
__device__ __forceinline__ void phase_prep(const Args& a, int l, LAS unsigned char* lds) {
    int tid_ = threadIdx.x; asm volatile("" : "+v"(tid_));
    const int tid = tid_, lane = tid & 63, wave = tid >> 6, G = gridDim.x;
    const int gw = blockIdx.x * 8 + wave, NGW = G * 8;
    const bf16_t* P = (const bf16_t*)(a.ws + WS_P);
    bf16_t* QN = (bf16_t*)(a.ws + WS_QN); bf16_t* KC = (bf16_t*)(a.ws + WS_KC); bf16_t* VT = (bf16_t*)(a.ws + WS_VT);
    float* ock = a.out + (size_t)41943040; float* ocv = a.out + (size_t)58720256;
    for (int item = blockIdx.x; item < 2560; item += G) {
        const int tb = item >> 3, h = item & 7, tok0 = tb * 64;
        const bool smp = tok0 >= NPROMPT;
        int b, n0, Nk, koff; size_t vbase;
        if (!smp) { b = tok0 >> 8; n0 = tok0 & 255; Nk = PSEQ; koff = 0; vbase = 0; }
        else { const int r2 = tok0 - NPROMPT; b = r2 >> 12; n0 = r2 & 4095; Nk = SNK; koff = PAST; vbase = (size_t)PB * 8 * 128 * PSEQ; }
        __syncthreads();
#pragma unroll
        for (int i = 0; i < 2; ++i) { const int piece = tid + 512 * i, r = piece >> 4, cc = piece & 15;
            const u32x4 v = *(const u32x4*)(P + (size_t)(tok0 + r) * INC + C_V + h * 128 + cc * 8);
            *(LAS u32x4*)(lds + r * 272 + cc * 16) = v;
            if (!smp) { float f[8]; unpack8(v, f); float* o = ocv + ((size_t)(b * DEPTH + l) * PSEQ + n0 + r) * 1024 + h * 128 + cc * 8;
                *(f32x4*)o = (f32x4){f[0], f[1], f[2], f[3]}; *(f32x4*)(o + 4) = (f32x4){f[4], f[5], f[6], f[7]}; } }
        __syncthreads();
#pragma unroll
        for (int i = 0; i < 2; ++i) { const int oc = tid + 512 * i, d = oc >> 3, pc = oc & 7, s = pc >> 1, hf = pc & 1;
            unsigned short e[8];
#pragma unroll
            for (int j = 0; j < 8; ++j) { const int key = 16 * s + 8 * (j >> 2) + 4 * hf + (j & 3); e[j] = *(const LAS unsigned short*)(lds + key * 272 + d * 2); }
            u32x4 w; w.x = e[0] | ((unsigned)e[1] << 16); w.y = e[2] | ((unsigned)e[3] << 16); w.z = e[4] | ((unsigned)e[5] << 16); w.w = e[6] | ((unsigned)e[7] << 16);
            *(u32x4*)(VT + vbase + ((size_t)(b * 8 + h) * 128 + d) * Nk + koff + n0 + pc * 8) = w; }
    }
    __syncthreads();
}

__device__ __forceinline__ void phase_fold(const Args& a) {
    int tid_ = threadIdx.x; asm volatile("" : "+v"(tid_));
    const size_t gt = (size_t)blockIdx.x * 512 + tid_, NT_ = (size_t)gridDim.x * 512;
    const bf16_t* ABTs = (const bf16_t*)(a.ws + WS_ABT) + (size_t)PB * 1024 * 512;
    bf16_t* FB = (bf16_t*)(a.ws + WS_T4096 + 32 * MiB);
    for (size_t ch = gt; ch < (size_t)SB * 1024 * 512; ch += NT_) {
        const int kk0 = (int)(ch & 511) * 8; const size_t row = ch >> 9;
        const bf16_t* A = ABTs + row * 8192; const bf16_t* B = A + 4096;
        const bool apart = kk0 < 2048; const bf16_t* X = apart ? A : B; const int f0 = apart ? kk0 : kk0 - 2048;
        float fw[8], mr[8]; unpack8(*(const u32x4*)(X + f0), fw); unpack8(*(const u32x4*)(X + 4096 - f0 - 8), mr);
        const float m0 = (f0 > 0) ? bf2f(X[4096 - f0]) : 0.f;
        float v[8];
        if (apart) { v[0] = (f0 == 0) ? fw[0] : fw[0] + m0;
#pragma unroll
            for (int e = 1; e < 8; ++e) v[e] = fw[e] + mr[8 - e]; }
        else { v[0] = (f0 == 0) ? bf2f(A[2048]) : fw[0] - m0;
#pragma unroll
            for (int e = 1; e < 8; ++e) v[e] = fw[e] - mr[8 - e]; }
        u32x4 o; o.x = cvtpk(v[0], v[1]); o.y = cvtpk(v[2], v[3]); o.z = cvtpk(v[4], v[5]); o.w = cvtpk(v[6], v[7]);
        *(u32x4*)(FB + row * 4096 + kk0) = o;
    }
}

__device__ __forceinline__ void attn_item(LAS unsigned char* lds, const bf16_t* Q, int Nq, const bf16_t* Kc, const bf16_t* Vt, int Nk, int q0,
                                          float lam, float onorm, const float* gsub, const bf16_t* za, bf16_t* Yo) {
    int tid_ = threadIdx.x; asm volatile("" : "+v"(tid_));
    const int tid = tid_, lane = tid & 63, wave = __builtin_amdgcn_readfirstlane(tid >> 6), r32 = lane & 31, hi = lane >> 5, c = wave >> 2, qs = wave & 3;
    bf16x8 qr[4];
    { const bf16_t* qp = Q + ((size_t)c * Nq + q0 + qs * 32 + r32) * 64 + hi * 8;
#pragma unroll
      for (int d0 = 0; d0 < 4; ++d0) qr[d0] = *(const bf16x8*)(qp + d0 * 16); }
    const int srow = wave * 8 + (lane >> 3), sch = (lane & 7) ^ ((srow >> 1) & 7);
    const bf16_t* k0src = Kc + (size_t)srow * 64 + sch * 8; const bf16_t* k1src = k0src + (size_t)Nk * 64;
    const bf16_t* v0src = Vt + (size_t)srow * Nk + sch * 8; const bf16_t* v1src = v0src + (size_t)64 * Nk;
    const int wpiece = wave * 1024;
#define ATT_DMA(stgoff, tt) do { \
        __builtin_amdgcn_global_load_lds((const unsigned*)(k0src + (size_t)(tt) * 4096), (LAS unsigned*)(lds + (stgoff) + wpiece), 16, 0, 0); \
        __builtin_amdgcn_global_load_lds((const unsigned*)(k1src + (size_t)(tt) * 4096), (LAS unsigned*)(lds + (stgoff) + 8192 + wpiece), 16, 0, 0); \
        __builtin_amdgcn_global_load_lds((const unsigned*)(v0src + (size_t)(tt) * 64), (LAS unsigned*)(lds + (stgoff) + 16384 + wpiece), 16, 0, 0); \
        __builtin_amdgcn_global_load_lds((const unsigned*)(v1src + (size_t)(tt) * 64), (LAS unsigned*)(lds + (stgoff) + 24576 + wpiece), 16, 0, 0); } while (0)
    const int swz = (r32 >> 1) & 7; int xo[4];
#pragma unroll
    for (int j = 0; j < 4; ++j) xo[j] = ((2 * j + hi) ^ swz) * 16;
    const int kro = c * 8192 + r32 * 128, vro = 16384 + r32 * 128;
    const int NT = Nk >> 6;
    ATT_DMA(0, 0);
    __syncthreads();
    f32x16 O[4];
#pragma unroll
    for (int i = 0; i < 4; ++i)
#pragma unroll
        for (int r = 0; r < 16; ++r) O[i][r] = 0.f;
    f32x16 negm;
#pragma unroll
    for (int r = 0; r < 16; ++r) negm[r] = 0.f;
    float m = 0.f, lsum = 0.f;
    bf16x8 pf[4];
#pragma unroll
    for (int i = 0; i < 4; ++i) pf[i] = (bf16x8){0, 0, 0, 0, 0, 0, 0, 0};
#define ATT_VLD(dst, stg, db) do { _Pragma("unroll") for (int i_ = 0; i_ < 4; ++i_) dst[i_] = *(const LAS bf16x8*)((stg) + vro + (db) * 4096 + xo[i_]); } while (0)
#define ATT_PVM(src, db) do { __builtin_amdgcn_s_setprio(1); _Pragma("unroll") for (int i_ = 0; i_ < 4; ++i_) O[db] = __builtin_amdgcn_mfma_f32_32x32x16_bf16(src[i_], pf[i_], O[db], 0, 0, 0); __builtin_amdgcn_s_setprio(0); } while (0)
#define SCHEDB() __builtin_amdgcn_sched_barrier(0)
    int so_prev = 65536, so_cur = 0, so_next = 32768;
    bf16x8 va[4], vb[4];
    for (int t = 0; t < NT; ++t) {
        LAS unsigned char* cur = lds + so_cur;
        if (t + 1 < NT) ATT_DMA(so_next, t + 1);
        bf16x8 kf[8];
        if (c == 1 && t > 0) { LAS unsigned char* prv = lds + so_prev;
            ATT_VLD(va, prv, 0); SCHEDB(); ATT_VLD(vb, prv, 1); SCHEDB();
            ATT_PVM(va, 0); SCHEDB(); ATT_VLD(va, prv, 2); SCHEDB();
            ATT_PVM(vb, 1); SCHEDB(); ATT_VLD(vb, prv, 3); SCHEDB();
            ATT_PVM(va, 2); SCHEDB();
#pragma unroll
            for (int d0 = 0; d0 < 4; ++d0) { kf[2 * d0] = *(const LAS bf16x8*)(cur + kro + xo[d0]); kf[2 * d0 + 1] = *(const LAS bf16x8*)(cur + kro + 4096 + xo[d0]); }
            SCHEDB(); ATT_PVM(vb, 3); SCHEDB();
        } else {
#pragma unroll
            for (int d0 = 0; d0 < 4; ++d0) { kf[2 * d0] = *(const LAS bf16x8*)(cur + kro + xo[d0]); kf[2 * d0 + 1] = *(const LAS bf16x8*)(cur + kro + 4096 + xo[d0]); }
            SCHEDB();
        }
        f32x16 S0, S1;
        __builtin_amdgcn_s_setprio(1);
        S0 = __builtin_amdgcn_mfma_f32_32x32x16_bf16(kf[0], qr[0], negm, 0, 0, 0);
        S1 = __builtin_amdgcn_mfma_f32_32x32x16_bf16(kf[1], qr[0], negm, 0, 0, 0);
#pragma unroll
        for (int d0 = 1; d0 < 4; ++d0) {
            S0 = __builtin_amdgcn_mfma_f32_32x32x16_bf16(kf[2 * d0], qr[d0], S0, 0, 0, 0);
            S1 = __builtin_amdgcn_mfma_f32_32x32x16_bf16(kf[2 * d0 + 1], qr[d0], S1, 0, 0, 0);
        }
        __builtin_amdgcn_s_setprio(0);
        SCHEDB();
        if (c == 0) { ATT_VLD(va, cur, 0); SCHEDB(); }
        float mx = fmaxf(S0[0], S1[0]);
#pragma unroll
        for (int r = 1; r < 16; ++r) mx = fmaxf(mx, fmaxf(S0[r], S1[r]));
        mx = fmaxf(mx, __shfl_xor(mx, 32));
        if (__any(mx > 8.0f)) {
            const float dl = fmaxf(mx, 0.f), al = __builtin_amdgcn_exp2f(-dl); m += dl; lsum *= al;
#pragma unroll
            for (int r = 0; r < 16; ++r) { S0[r] -= dl; S1[r] -= dl; negm[r] = -m; }
#pragma unroll
            for (int i = 0; i < 4; ++i)
#pragma unroll
                for (int r = 0; r < 16; ++r) O[i][r] *= al;
        }
        float ps = 0.f;
#pragma unroll
        for (int r = 0; r < 16; ++r) { S0[r] = __builtin_amdgcn_exp2f(S0[r]); S1[r] = __builtin_amdgcn_exp2f(S1[r]); ps += S0[r] + S1[r]; }
        lsum += ps;
        { u32x4 w;
          w.x = cvtpk(S0[0], S0[1]); w.y = cvtpk(S0[2], S0[3]); w.z = cvtpk(S0[4], S0[5]); w.w = cvtpk(S0[6], S0[7]); pf[0] = __builtin_bit_cast(bf16x8, w);
          w.x = cvtpk(S0[8], S0[9]); w.y = cvtpk(S0[10], S0[11]); w.z = cvtpk(S0[12], S0[13]); w.w = cvtpk(S0[14], S0[15]); pf[1] = __builtin_bit_cast(bf16x8, w);
          w.x = cvtpk(S1[0], S1[1]); w.y = cvtpk(S1[2], S1[3]); w.z = cvtpk(S1[4], S1[5]); w.w = cvtpk(S1[6], S1[7]); pf[2] = __builtin_bit_cast(bf16x8, w);
          w.x = cvtpk(S1[8], S1[9]); w.y = cvtpk(S1[10], S1[11]); w.z = cvtpk(S1[12], S1[13]); w.w = cvtpk(S1[14], S1[15]); pf[3] = __builtin_bit_cast(bf16x8, w); }
        if (c == 0) { SCHEDB(); ATT_VLD(vb, cur, 1); SCHEDB(); ATT_PVM(va, 0); SCHEDB(); ATT_VLD(va, cur, 2); SCHEDB(); ATT_PVM(vb, 1); SCHEDB(); ATT_VLD(vb, cur, 3); SCHEDB(); ATT_PVM(va, 2); SCHEDB(); ATT_PVM(vb, 3); SCHEDB(); }
        __syncthreads();
        { const int tmp = so_prev; so_prev = so_cur; so_cur = so_next; so_next = tmp; }
    }
    if (c == 1) { LAS unsigned char* prv = lds + so_prev; ATT_VLD(va, prv, 0); ATT_VLD(vb, prv, 1); ATT_PVM(va, 0); ATT_VLD(va, prv, 2); ATT_PVM(vb, 1); ATT_VLD(vb, prv, 3); ATT_PVM(va, 2); ATT_PVM(vb, 3); }
#undef ATT_VLD
#undef ATT_DMA
#undef ATT_PVM
#undef SCHEDB
    __syncthreads();
    lsum += __shfl_xor(lsum, 32);
    const float il = 1.0f / lsum;
    LAS float* xb = (LAS float*)(lds + 65536) + qs * 4096;
    if (c == 1) {
#pragma unroll
        for (int db = 0; db < 4; ++db)
#pragma unroll
            for (int r = 0; r < 16; ++r) xb[(db * 16 + r) * 64 + lane] = O[db][r] * il;
    }
    __syncthreads();
    if (c == 0) {
        float ss = 0.f;
#pragma unroll
        for (int db = 0; db < 4; ++db)
#pragma unroll
            for (int r = 0; r < 16; ++r) { const float o = O[db][r] * il - lam * xb[(db * 16 + r) * 64 + lane]; O[db][r] = o; ss += o * o; }
        ss += __shfl_xor(ss, 32);
        const float rs = onorm / sqrtf(ss * (1.0f / 128.0f) + EPS);
        const int tok = q0 + qs * 32 + r32;
        const bf16_t* zr = za + (size_t)tok * INC; bf16_t* yo = Yo + (size_t)tok * D;
#pragma unroll
        for (int db = 0; db < 4; ++db)
#pragma unroll
            for (int g = 0; g < 4; ++g) { const int d = 32 * db + 8 * g + 4 * hi;
                const f32x4 gs = *(const f32x4*)(gsub + d); const u32x2 z = *(const u32x2*)(zr + d);
                const float o0 = O[db][4 * g] * rs * gs.x * bf2f(z.x & 0xffffu), o1 = O[db][4 * g + 1] * rs * gs.y * bf2f(z.x >> 16);
                const float o2 = O[db][4 * g + 2] * rs * gs.z * bf2f(z.y & 0xffffu), o3 = O[db][4 * g + 3] * rs * gs.w * bf2f(z.y >> 16);
                u32x2 w; w.x = cvtpk(o0, o1); w.y = cvtpk(o2, o3); *(u32x2*)(yo + d) = w; }
    }
    __syncthreads();
}
__device__ __forceinline__ void phase_attn(const Args& a, int l, LAS unsigned char* lds) {
    const int G = gridDim.x;
    const bf16_t* P = (const bf16_t*)(a.ws + WS_P); bf16_t* Y = (bf16_t*)(a.ws + WS_Y);
    const bf16_t* QN = (const bf16_t*)(a.ws + WS_QN); const bf16_t* KC = (const bf16_t*)(a.ws + WS_KC); const bf16_t* VT = (const bf16_t*)(a.ws + WS_VT);
    const float lam = ((const float*)(a.ws + WS_MOD))[4 * 5 * 6144 + l];
    const float lam_init = 0.8f - 0.6f * expf(-0.3f * (float)l);
    const float* gsub = a.in[15] + l * 128;
    for (int L = blockIdx.x; L < 1280; L += G) {
        if (L < 1024) { const int b = L >> 8, h = L & 7, qb = (L >> 3) & 31;
            const size_t qoff = (size_t)PB * 16 * PSEQ * 64 + (size_t)(b * 8 + h) * 2 * SSEQ * 64;
            const size_t koff = (size_t)PB * 16 * PSEQ * 64 + (size_t)(b * 8 + h) * 2 * SNK * 64;
            const size_t voff = (size_t)PB * 8 * 128 * PSEQ + (size_t)(b * 8 + h) * 128 * SNK;
            const size_t tok0 = (size_t)NPROMPT + (size_t)b * SSEQ;
            attn_item(lds, QN + qoff, SSEQ, KC + koff, VT + voff, SNK, qb * 128, lam, 1.0f - lam_init, gsub + 0, P + tok0 * INC + C_ZA + h * 128, Y + tok0 * D + 1024 + h * 128);
        } else { const int M_ = L - 1024, b = M_ >> 4, h = (M_ >> 1) & 7, qb = M_ & 1;
            const size_t qoff = (size_t)(b * 8 + h) * 2 * PSEQ * 64, voff = (size_t)(b * 8 + h) * 128 * PSEQ;
            const size_t tok0 = (size_t)b * PSEQ;
            attn_item(lds, QN + qoff, PSEQ, KC + qoff, VT + voff, PSEQ, qb * 128, lam, 1.0f - lam_init, gsub + 0, P + tok0 * INC + C_ZA + h * 128, Y + tok0 * D + 1024 + h * 128);
        }
    }
}

#define XB_TMO      128
#define XB_XCNT(j)  (256  + 64 * (j))
#define XB_XSUB(j)  (1280 + 64 * (j))
#define XB_XGEN(j)  (2304 + 64 * (j))
#define XB_TOP      3328
#define XB_TOPGEN   3392
#define XCD_BAR_WORDS 3456
#define XB_SPIN_CAP (1u << 20)
__device__ __forceinline__ unsigned xb_ld(unsigned* p)              { return __hip_atomic_load(p, __ATOMIC_RELAXED, __HIP_MEMORY_SCOPE_AGENT); }
__device__ __forceinline__ unsigned xb_add(unsigned* p, unsigned v) { return __hip_atomic_fetch_add(p, v, __ATOMIC_RELAXED, __HIP_MEMORY_SCOPE_AGENT); }
__device__ __forceinline__ unsigned xb_xcc_id() { return (unsigned)__builtin_amdgcn_s_getreg((3 << 11) | 20) & 0xFu; }
#define XB_SPIN(cond, bar) do { unsigned _sp = 0; while (cond) { __builtin_amdgcn_s_sleep(1); \
    if ((++_sp & 255u) == 0u) { if (xb_ld(&(bar)[XB_TMO])) break; if (_sp > XB_SPIN_CAP) { atomicAdd(&(bar)[XB_TMO], 1u); break; } } } } while (0)
struct XcdBarrier { unsigned* bar; unsigned x; volatile LAS unsigned* st; };
__device__ __forceinline__ XcdBarrier xcd_barrier_post(unsigned* bar, volatile LAS unsigned* st) {
    XcdBarrier b; b.bar = bar; b.x = xb_xcc_id(); b.st = st;
    if (threadIdx.x == 0) (void)xb_add(&bar[XB_XCNT(b.x)], 1u);
    return b;
}
__device__ __forceinline__ void xcd_barrier_complete(unsigned* bar, unsigned x, unsigned& nloc, unsigned& nx) {
    const unsigned G = gridDim.x * gridDim.y * gridDim.z;
    unsigned sum, cnt, mine, sp = 0u;
    for (;;) {
        sum = 0u; cnt = 0u; mine = 0u;
#pragma unroll
        for (unsigned j = 0; j < 16; ++j) { const unsigned c = xb_ld(&bar[XB_XCNT(j)]); sum += c; cnt += (c > 0u) ? 1u : 0u; mine = (j == x) ? c : mine; }
        if (sum == G) break;
        __builtin_amdgcn_s_sleep(1);
        if ((++sp & 255u) == 0u) { if (xb_ld(&bar[XB_TMO])) break; if (sp > XB_SPIN_CAP) { atomicAdd(&bar[XB_TMO], 1u); break; } }
    }
    nloc = mine > 0u ? mine : 1u; nx = cnt > 0u ? cnt : 1u;
}
__device__ __forceinline__ void xcd_barrier(const XcdBarrier& b) {
    asm volatile("s_waitcnt vmcnt(0)" ::: "memory");
    __syncthreads();
    if (threadIdx.x == 0) {
        unsigned* bar = b.bar;
        __builtin_amdgcn_s_waitcnt(0);
        unsigned nloc = b.st[0], nx = b.st[1];
        if (nloc == 0u) { xcd_barrier_complete(bar, b.x, nloc, nx); b.st[0] = nloc; b.st[1] = nx; }
        const unsigned old = xb_add(&bar[XB_XSUB(b.x)], 1u);
        const unsigned gen = old / nloc;
        if (old + 1u == (gen + 1u) * nloc) {
            __builtin_amdgcn_fence(__ATOMIC_RELEASE, "agent");
            asm volatile("s_waitcnt vmcnt(0)" ::: "memory");
            const unsigned og = xb_add(&bar[XB_TOP], 1u);
            const unsigned tg = og / nx;
            if (og + 1u == (tg + 1u) * nx) xb_add(&bar[XB_TOPGEN], 1u);
            else XB_SPIN(xb_ld(&bar[XB_TOPGEN]) == tg, bar);
            __builtin_amdgcn_fence(__ATOMIC_ACQUIRE, "agent");
            xb_add(&bar[XB_XGEN(b.x)], 1u);
            asm volatile("s_waitcnt vmcnt(0)" ::: "memory");
        } else {
            XB_SPIN(xb_ld(&bar[XB_XGEN(b.x)]) == gen, bar);
            __builtin_amdgcn_fence(__ATOMIC_ACQUIRE, "agent");
            asm volatile("s_waitcnt vmcnt(0)" ::: "memory");
        }
    }
    __syncthreads();
}

#ifndef PHMASK
#define PHMASK 0xFFFF
#endif
#define REP_IN 1
#define REP_ATTN 1
#define REP_POS 1
#define REP_PREP 1
#define REP_MERGE 1
#define REP_PRE0 1
#define REP_NORM 1
#define REP_CHAN 1
__global__ void __launch_bounds__(512, 2) fwd_kernel(Args a) {
    extern __shared__ __attribute__((aligned(16))) unsigned char lds_raw[];
    LAS unsigned char* lds = (LAS unsigned char*)lds_raw;
    cg::grid_group grid = cg::this_grid();
    const int G = gridDim.x, c = blockIdx.x;
    unsigned char* ws = a.ws;
    int ph = 0;
    volatile LAS unsigned* bst = (volatile LAS unsigned*)(lds + 131072 + 512);
    if (threadIdx.x < 2) bst[threadIdx.x] = 0u;
    __syncthreads();
    const XcdBarrier xbar = xcd_barrier_post((unsigned*)(ws + WS_CTL), bst);
#define SEAM() do { if (a.ph_lo <= ph && ph + 1 < a.ph_hi) { if (ph == 0) grid.sync(); else xcd_barrier(xbar); } ++ph; } while (0)
#define IN_PH() (a.ph_lo <= ph && ph < a.ph_hi)
    if (IN_PH()) { if constexpr (PHMASK & 1) for (int rep = 0; rep < REP_PRE0; ++rep) { phase_pre0(a, lds); __syncthreads(); } }
    SEAM();
    if (IN_PH()) { if constexpr (PHMASK & 2) phase_pre1(a); }
    SEAM();
#pragma unroll 1
    for (int l = 0; l < DEPTH; ++l) {
        if (IN_PH()) { if constexpr (PHMASK & 4) for (int rep = 0; rep < REP_NORM; ++rep) phase_norm(a, l); }
        SEAM();
        const char* Hb = (const char*)(ws + WS_H); const char* WIl = (const char*)(ws + WS_WIN) + (size_t)l * INC * D * 2; const size_t trs_ = (size_t)256 * D * 2;
        const EpiIn EI{(bf16_t*)(ws + WS_P), (bf16_t*)(ws + WS_QN), (bf16_t*)(ws + WS_KC), a.out + (size_t)41943040, a.in[13] + l * 64, a.in[14] + l * 64, (const float*)(ws + WS_TAB + 512 * 1024), l, ws + WS_GN, ws + WS_ZN};
        const pg8::Gemm gI{D, D, D};
        if (IN_PH()) if constexpr (PHMASK & 8) {
            { pg8::Order<pg8::MapGrid> S{80 * 32, G, c, pg8::MapGrid{Hb, WIl, 80, 32, trs_, trs_, 0, 0}};
              for (int rep = 0; rep < REP_IN; ++rep) pg8::gemm_phase(lds, gI, S, EI); }
            { pg8::Order<pg8::MapGrid> S{64 * 8, G, c, pg8::MapGrid{Hb, WIl, 64, 8, trs_, trs_, 0, 32}};
              pg8::gemm_phase(lds, gI, S, EI); }
        }
        SEAM();
        if (IN_PH()) if constexpr (PHMASK & 16) {
            if (c < (G >> 1)) { pg8::Order<pg8::MapGrid> S{16 * 8, G >> 1, c, pg8::MapGrid{Hb, WIl, 16, 8, trs_, trs_, 64, 32}}; pg8::gemm_phase(lds, gI, S, EI); }
            else { pg8::Gemm g{256, INC, 256};
                pg8::Order<MapChan> S{640, G - (G >> 1), c - (G >> 1), MapChan{(const char*)(ws + WS_TAB + 256 * 1024), (const char*)(ws + WS_P)}};
                EpiStore E{(bf16_t*)(ws + WS_ABT)};
                for (int rep = 0; rep < REP_CHAN; ++rep) pg8::gemm_phase(lds, g, S, E); }
        }
        SEAM();
        if (IN_PH()) {
            if constexpr (PHMASK & 32) for (int rep = 0; rep < REP_PREP; ++rep) phase_prep(a, l, lds);
            phase_fold(a);
        }
        SEAM();
        if (IN_PH()) if constexpr (PHMASK & 64) {
            { pg8::Gemm g{4096, 4096, 4096};
              pg8::Order<MapPosS> S{256, G, c, MapPosS{(const char*)(ws + WS_T4096), (const char*)(ws + WS_T4096 + 32 * MiB)}};
              EpiPos E{ws + WS_ZN, (bf16_t*)(ws + WS_Y)};
              for (int rep = 0; rep < REP_POS; ++rep) pg8::gemm_phase(lds, g, S, E); }
            { pg8::Gemm g{512, 512, 512};
              pg8::Order<MapPosP> S{64, G, c, MapPosP{(const char*)(ws + WS_TAB), (const char*)(ws + WS_ABT)}};
              EpiPos E{ws + WS_ZN, (bf16_t*)(ws + WS_Y)};
              pg8::gemm_phase(lds, g, S, E); }
            if constexpr (PHMASK & 128) for (int rep = 0; rep < REP_ATTN; ++rep) phase_attn(a, l, lds);
        }
        SEAM();
        const char* Yb = (const char*)(ws + WS_Y); const char* MGb = (const char*)(ws + WS_H);
        const char* WMl = (const char*)(ws + WS_WM) + (size_t)l * D * D * 2; const char* WOl = (const char*)(ws + WS_WO) + (size_t)l * D * D * 2;
        const size_t trs = (size_t)256 * D * 2;
        const EpiMerge EM{ws + WS_GN, (bf16_t*)(ws + WS_H)};
        const EpiOut EO{(l == 0) ? a.in[0] : a.out, (l == 0) ? a.in[1] : a.out + (size_t)NPROMPT * D, a.out, (const float*)(ws + WS_MOD) + (size_t)l * 5 * 6144};
        const pg8::Gemm gD{D, D, D};
        if (IN_PH()) if constexpr (PHMASK & 256) {
            pg8::Order<pg8::MapGrid> S{64 * 8, G, c, pg8::MapGrid{Yb, WMl, 64, 8, trs, trs, 0, 0}};
            for (int rep = 0; rep < REP_MERGE; ++rep) pg8::gemm_phase(lds, gD, S, EM);
        }
        SEAM();
        if (IN_PH()) if constexpr (PHMASK & 512) {
            if (c < (G >> 1)) { pg8::Order<pg8::MapGrid> S{16 * 8, G >> 1, c, pg8::MapGrid{Yb, WMl, 16, 8, trs, trs, 64, 0}}; pg8::gemm_phase(lds, gD, S, EM); }
            else { pg8::Order<pg8::MapGrid> S{16 * 8, G - (G >> 1), c - (G >> 1), pg8::MapGrid{MGb, WOl, 16, 8, trs, trs, 0, 0}}; pg8::gemm_phase(lds, gD, S, EO); }
        }
        SEAM();
        if (IN_PH()) if constexpr (PHMASK & 512) {
            pg8::Order<pg8::MapGrid> S{64 * 8, G, c, pg8::MapGrid{MGb, WOl, 64, 8, trs, trs, 16, 0}};
            pg8::gemm_phase(lds, gD, S, EO);
        }
        SEAM();
    }
#undef SEAM
#undef IN_PH
}
constexpr int N_PHASES = 2 + 8 * DEPTH;

extern "C" void kernel_launch(void* const* d_in, const int* in_sizes, int n_in, void* d_out, int out_size, void* d_ws, size_t ws_size, hipStream_t stream) {
    static int grid = 0;
    if (grid == 0) {
        if (n_in != 20 || ws_size < WS_END) { fprintf(stderr, "kernel_launch: unexpected n_in %d or ws_size %zu (< %zu)\n", n_in, ws_size, (size_t)WS_END); grid = -1; return; }
        int dev = 0, cus = 0, per_cu = 0;
        hipGetDevice(&dev); hipDeviceGetAttribute(&cus, hipDeviceAttributeMultiprocessorCount, dev);
        if (hipFuncSetAttribute((const void*)fwd_kernel, hipFuncAttributeMaxDynamicSharedMemorySize, LDS_BYTES) != hipSuccess) { fprintf(stderr, "kernel_launch: hipFuncSetAttribute failed\n"); grid = -1; return; }
        hipOccupancyMaxActiveBlocksPerMultiprocessor(&per_cu, (const void*)fwd_kernel, 512, LDS_BYTES);
        (void)hipGetLastError();
        if (per_cu < 1) { fprintf(stderr, "kernel_launch: occupancy query says %d blocks per CU\n", per_cu); per_cu = 1; }
        grid = cus * 1;
    }
    if (grid < 0) return;
    if (hipMemsetAsync((char*)d_ws + WS_CTL, 0, XCD_BAR_WORDS * 4, stream) != hipSuccess) { fprintf(stderr, "kernel_launch: hipMemsetAsync failed\n"); return; }
    Args a{};
    for (int i = 0; i < 20; ++i) a.in[i] = (const float*)d_in[i];
    a.out = (float*)d_out; a.ws = (unsigned char*)d_ws; a.ph_lo = 0; a.ph_hi = N_PHASES;
    void* params[] = {&a};
    hipError_t e = hipLaunchCooperativeKernel((const void*)fwd_kernel, dim3(grid), dim3(512), params, LDS_BYTES, stream);
    if (e != hipSuccess) fprintf(stderr, "cooperative launch failed: %s (grid %d)\n", hipGetErrorString(e), grid);
}
```

```cpp
#include <hip/hip_runtime.h>
#include <hip/hip_cooperative_groups.h>
#include <cstdio>
#include <cstdint>
namespace cg = cooperative_groups;

#define LAS __attribute__((address_space(3)))
typedef unsigned short bf16_t;
typedef short bf16x8 __attribute__((ext_vector_type(8)));
typedef float f32x2 __attribute__((ext_vector_type(2)));
typedef float f32x4 __attribute__((ext_vector_type(4)));
typedef float f32x16 __attribute__((ext_vector_type(16)));
typedef unsigned u32x2 __attribute__((ext_vector_type(2)));
typedef unsigned u32x4 __attribute__((ext_vector_type(4)));
typedef __bf16 bf16x2_t __attribute__((ext_vector_type(2)));

constexpr int D = 2048, DEPTH = 4, NTOK = 20480, NPROMPT = 4096, INC = 10240;
constexpr int PB = 16, PSEQ = 256, SB = 4, SSEQ = 4096, PAST = 512, SNK = PAST + SSEQ;
constexpr int C_UF = 0, C_ZF = 1024, C_Q = 2048, C_K = 3072, C_V = 4096, C_ZA = 5120, C_GF = 6144, C_GA = 8192;
constexpr float EPS = 1e-6f;
constexpr float LOG2E = 1.4426950408889634f;
constexpr float QSCALE = 0.125f * LOG2E;

constexpr size_t MiB = 1u << 20;
constexpr size_t WS_CTL = 0;
constexpr size_t WS_WIN = 1 * MiB;
constexpr size_t WS_WM = WS_WIN + 160 * MiB;
constexpr size_t WS_WO = WS_WM + 32 * MiB;
constexpr size_t WS_MODP = WS_WO + 32 * MiB;
constexpr size_t WS_MOD = WS_MODP + 8 * MiB;
constexpr size_t WS_TAB = WS_MOD + 1 * MiB;
constexpr size_t WS_T4096 = WS_TAB + 1 * MiB;
constexpr size_t WS_H = WS_T4096 + 64 * MiB;
constexpr size_t WS_P = WS_H + 80 * MiB;
constexpr size_t WS_ABT = WS_P + 400 * MiB;
constexpr size_t WS_Y = WS_ABT + 80 * MiB;
constexpr size_t WS_QN = WS_Y + 80 * MiB;
constexpr size_t WS_KC = WS_QN + 40 * MiB;
constexpr size_t WS_VT = WS_KC + 44 * MiB;
constexpr size_t WS_GN = WS_VT + 44 * MiB;
constexpr size_t WS_ZN = WS_GN + 160 * MiB;
constexpr size_t WS_END = WS_ZN + 40 * MiB;
__device__ __forceinline__ size_t nat_off(int tile, int ai, int m, int bj, int wave, int lane) { return ((((size_t)tile * 8 + ai * 4 + m) * 2 + bj) * 8 + wave) * 1024 + (size_t)lane * 16; }
constexpr int LDS_BYTES = 147456;

__device__ __forceinline__ float bf2f(unsigned b) { return __uint_as_float(b << 16); }
__device__ __forceinline__ unsigned cvtpk(float lo, float hi) { f32x2 v = {lo, hi}; bf16x2_t b = __builtin_convertvector(v, bf16x2_t); return __builtin_bit_cast(unsigned, b); }
__device__ __forceinline__ float sigmoidf_(float x) { return __builtin_amdgcn_rcpf(1.0f + __builtin_amdgcn_exp2f(-x * LOG2E)); }
__device__ __forceinline__ float siluf_(float x) { return x * sigmoidf_(x); }
__device__ __forceinline__ float wave_sum(float v) {
#pragma unroll
    for (int o = 1; o < 64; o <<= 1) v += __shfl_xor(v, o);
    return v;
}
__device__ __forceinline__ void unpack8(const u32x4 w, float* f) {
    f[0] = bf2f(w.x & 0xffffu); f[1] = bf2f(w.x >> 16); f[2] = bf2f(w.y & 0xffffu); f[3] = bf2f(w.y >> 16);
    f[4] = bf2f(w.z & 0xffffu); f[5] = bf2f(w.z >> 16); f[6] = bf2f(w.w & 0xffffu); f[7] = bf2f(w.w >> 16);
}

namespace pg8 {
constexpr int BM = 256, BK = 64, HALF = 128, HTB = HALF * BK * 2, STAGE_BYTES = 8 * HTB, NXCD = 8, WGM = 8;
__host__ __device__ __forceinline__ int lds_byte(int r, int c) { const int st = (r >> 4) * 2 + (c >> 5), rr = r & 15, cc = c & 31, ob = rr * 64 + cc * 2; return st * 1024 + (ob ^ (((ob >> 9) & 1) << 5)); }
__host__ __device__ __forceinline__ void stage_rc(int b, int& R, int& C) { const int st = b / 1024, sb = b % 1024, swz = sb ^ (((sb >> 9) & 1) << 5); R = (st >> 1) * 16 + swz / 64; C = (st & 1) * 32 + (swz % 64) / 2; }
__host__ __device__ __forceinline__ int perm32(int rho) { const int n = rho >> 4, i = rho & 15; return 8 * (i >> 2) + 4 * n + (i & 3); }

struct Unit { const char* aP; const char* bP; size_t co; int ldc; int r0, c0; };
struct Gemm { int lda, ldb, K; };

template <class Map> struct Order {
    int n, G, c; Map map;
    __device__ __forceinline__ bool next(int i, Unit& u) const { const long L = (long)i * G + c; if (L >= n) return false; map((int)L, u); return true; }
};
struct MapGrid {
    const char* A; const char* B; int nM, nN; size_t ars, brs; int pm0, pn0;
    __device__ __forceinline__ void operator()(int L, Unit& u) const {
        const int nwg = nM * nN; int wgid = L;
        { const int q = nwg / NXCD, r = nwg % NXCD, xcd = wgid % NXCD, off = wgid / NXCD; wgid = (xcd < r ? xcd * (q + 1) : r * (q + 1) + (xcd - r) * q) + off; }
        const int nig = WGM * nN, gid = wgid / nig, fm = gid * WGM, gsz = (nM - fm) < WGM ? (nM - fm) : WGM;
        const int pm = pm0 + fm + ((wgid % nig) % gsz), pn = pn0 + (wgid % nig) / gsz;
        u.aP = A + (size_t)pm * ars; u.bP = B + (size_t)pn * brs; u.r0 = pm * BM; u.c0 = pn * BM; u.co = 0; u.ldc = 0;
    }
};

template <class Epi, class Sched>
__device__ __forceinline__ void gemm_phase(LAS unsigned char* lds, const Gemm g, const Sched& S, const Epi& E) {
    int tid_ = threadIdx.x; asm volatile("" : "+v"(tid_));
    const int tid = tid_, wid = __builtin_amdgcn_readfirstlane(tid >> 6), lane = tid & 63, wr = wid >> 2, wc = wid & 3, fr = lane & 15, fq = lane >> 4;
    const int K = g.K, nt = K / BK;
    unsigned voffA[2], voffB[2];
#pragma unroll
    for (int i = 0; i < 2; ++i) { int R, C; stage_rc(tid * 16 + i * 8192, R, C); const int Rb = Epi::CH64 ? (64 * (R >> 5) + perm32(R & 31)) : Epi::PERM ? ((R & ~31) + perm32(R & 31)) : R;
        voffA[i] = (unsigned)(R * g.lda + C) * 2u; voffB[i] = (unsigned)(Rb * g.ldb + C) * 2u; }
    const size_t kstep = (size_t)(BK * 2);
    const size_t hstepA = (size_t)HALF * g.lda * 2, hstepB = (size_t)(Epi::CH64 ? 32 : HALF) * g.ldb * 2;
    const unsigned ldsw = (unsigned)wid * 1024u;
    const int aoff = lds_byte(wr * 64 + fr, fq * 8), boff = lds_byte(wc * 32 + fr, fq * 8);
#define PG8_SA(b, h) (((b) * 2 + (h)) * HTB)
#define PG8_SB(b, h) ((4 + (b) * 2 + (h)) * HTB)
#define PG8_STAGE(bufoff, gbase, voff) do { const char* _gb = (const char*)(gbase); asm volatile("" : "+s"(_gb)); _Pragma("unroll") for (int _i = 0; _i < 2; ++_i) \
        __builtin_amdgcn_global_load_lds((const unsigned*)(_gb + (voff)[_i]), (LAS unsigned*)(lds + (bufoff) + ldsw + _i * 8192), 16, 0, 0); } while (0)
#define PG8_LDA(dst, b, h) do { _Pragma("unroll") for (int m = 0; m < 4; ++m) _Pragma("unroll") for (int k = 0; k < 2; ++k) dst[m][k] = *(const LAS bf16x8*)(lds + PG8_SA(b, h) + aoff + m * 2048 + k * 1024); } while (0)
#define PG8_LDB(dst, b, h) do { _Pragma("unroll") for (int n = 0; n < 2; ++n) _Pragma("unroll") for (int k = 0; k < 2; ++k) dst[n][k] = *(const LAS bf16x8*)(lds + PG8_SB(b, h) + boff + n * 2048 + k * 1024); } while (0)
#define PG8_MMA(ai, bj, At, Bt) do { __builtin_amdgcn_s_setprio(1); _Pragma("unroll") for (int m = 0; m < 4; ++m) _Pragma("unroll") for (int n = 0; n < 2; ++n) _Pragma("unroll") for (int k = 0; k < 2; ++k) \
        acc[ai][bj][m][n] = __builtin_amdgcn_mfma_f32_16x16x32_bf16(Bt[n][k], At[m][k], acc[ai][bj][m][n], 0, 0, 0); __builtin_amdgcn_s_setprio(0); } while (0)
#define PG8_WAIT_V(n) asm volatile("s_waitcnt vmcnt(" #n ")" ::: "memory")
#define PG8_WAIT_L(n) asm volatile("s_waitcnt lgkmcnt(" #n ")" ::: "memory")
#define PG8_BAR __builtin_amdgcn_s_barrier()
#define PG8_SCHED __builtin_amdgcn_sched_barrier(0)
    Unit cur, nxt; int ui = 0;
    if (!S.next(0, cur)) return;
    f32x4 acc[2][2][4][2];
#pragma unroll
    for (int a = 0; a < 2; ++a)
#pragma unroll
        for (int b = 0; b < 2; ++b)
#pragma unroll
            for (int m = 0; m < 4; ++m)
#pragma unroll
                for (int n = 0; n < 2; ++n) acc[a][b][m][n] = (f32x4){0.f, 0.f, 0.f, 0.f};
    bf16x8 At[4][2], B0[2][2], B1[2][2];
    const char* cA = cur.aP; const char* cB = cur.bP;
    PG8_STAGE(PG8_SB(0, 0), cB, voffB); PG8_STAGE(PG8_SB(0, 1), cB + hstepB, voffB); PG8_STAGE(PG8_SA(0, 0), cA, voffA); PG8_STAGE(PG8_SA(0, 1), cA + hstepA, voffA);
    if (wr == 1) PG8_BAR;
    PG8_WAIT_V(2); PG8_BAR;
    PG8_STAGE(PG8_SB(1, 0), cB + kstep, voffB); PG8_STAGE(PG8_SA(1, 0), cA + kstep, voffA); PG8_STAGE(PG8_SB(1, 1), cB + hstepB + kstep, voffB);
    PG8_WAIT_V(6); PG8_BAR;
    for (;;) {
        const bool has_next = S.next(ui + 1, nxt);
        const char* nA = has_next ? nxt.aP : cA; const char* nB = has_next ? nxt.bP : cB;
#pragma unroll 1
        for (int t = 0; t < nt; t += 2) {
            const bool last = (t == nt - 2);
            const char* a1 = cA + (size_t)(t + 1) * kstep;
            const char* a2 = last ? nA : cA + (size_t)(t + 2) * kstep; const char* b2 = last ? nB : cB + (size_t)(t + 2) * kstep;
            const char* a3 = a2 + kstep; const char* b3 = b2 + kstep;
            if constexpr (Epi::HAS_MID) { if (t == (nt >> 1)) E.mid(acc, cur, wr, wc, fr, fq); }
            PG8_LDB(B0, 0, 0); PG8_LDB(B1, 0, 1); PG8_SCHED; PG8_LDA(At, 0, 0); PG8_STAGE(PG8_SA(1, 1), a1 + hstepA, voffA);
            PG8_WAIT_V(8); PG8_WAIT_L(0); PG8_BAR; PG8_MMA(0, 0, At, B0); PG8_MMA(0, 1, At, B1); PG8_BAR; PG8_SCHED;
            PG8_LDA(At, 0, 1); PG8_STAGE(PG8_SB(0, 0), b2, voffB); PG8_STAGE(PG8_SB(0, 1), b2 + hstepB, voffB); PG8_STAGE(PG8_SA(0, 0), a2, voffA);
            PG8_WAIT_V(8); PG8_WAIT_L(0); PG8_BAR; PG8_MMA(1, 0, At, B0); PG8_MMA(1, 1, At, B1); PG8_BAR; PG8_SCHED;
            PG8_LDB(B0, 1, 0); PG8_LDB(B1, 1, 1); PG8_SCHED; PG8_LDA(At, 1, 0); PG8_STAGE(PG8_SA(0, 1), a2 + hstepA, voffA);
            PG8_WAIT_V(8); PG8_WAIT_L(0); PG8_BAR; PG8_MMA(0, 0, At, B0); PG8_MMA(0, 1, At, B1); PG8_BAR; PG8_SCHED;
            PG8_LDA(At, 1, 1); PG8_STAGE(PG8_SB(1, 0), b3, voffB); PG8_STAGE(PG8_SB(1, 1), b3 + hstepB, voffB); PG8_STAGE(PG8_SA(1, 0), a3, voffA);
            PG8_WAIT_V(8); PG8_WAIT_L(0); PG8_BAR; PG8_MMA(1, 0, At, B0); PG8_MMA(1, 1, At, B1); PG8_BAR; PG8_SCHED;
        }
        if (wr == 0) PG8_BAR;
        E(acc, cur, wr, wc, fr, fq);
        if constexpr (Epi::PROBE2) E(acc, cur, wr, wc, fr, fq);
        if (!has_next) break;
#pragma unroll
        for (int a = 0; a < 2; ++a)
#pragma unroll
            for (int b = 0; b < 2; ++b)
#pragma unroll
                for (int m = 0; m < 4; ++m)
#pragma unroll
                    for (int n = 0; n < 2; ++n) acc[a][b][m][n] = (f32x4){0.f, 0.f, 0.f, 0.f};
        cur = nxt; cA = nA; cB = nB; ++ui;
        if (wr == 1) PG8_BAR;
    }
    PG8_WAIT_V(0);
    PG8_BAR;
#undef PG8_SA
#undef PG8_SB
#undef PG8_STAGE
#undef PG8_LDA
#undef PG8_LDB
#undef PG8_MMA
#undef PG8_WAIT_V
#undef PG8_WAIT_L
#undef PG8_BAR
#undef PG8_SCHED
}
}
using pg8::Unit;


struct EpiIn {
    static constexpr bool PERM = true, HAS_MID = false, PROBE2 = false, CH64 = true;
    bf16_t* P; bf16_t* QN; bf16_t* KC; float* ock; const float* gq; const float* gk; const float* RT; int l; unsigned char* GN; unsigned char* ZN;
    __device__ __forceinline__ void operator()(const f32x4 (&acc)[2][2][4][2], const Unit& u, int wr, int wc, int fr, int fq) const {
        const int pn = u.c0 >> 8;
        const int row0 = u.r0 + wr * 64 + fr;
        if (pn >= 8 && pn < 16) {
            const bool isq = pn < 12, smp = u.r0 >= NPROMPT;
            const int hc = ((u.c0 - (isq ? C_Q : C_K)) >> 6) + wc;
            const float* gp = (isq ? gq : gk) + 8 * fq;
            const f32x4 g00 = *(const f32x4*)gp, g01 = *(const f32x4*)(gp + 4), g10 = *(const f32x4*)(gp + 32), g11 = *(const f32x4*)(gp + 36);
            const bool isx2 = fq >= 2; const int jb = 8 * (fq & 1);
#pragma unroll
            for (int ai = 0; ai < 2; ++ai)
#pragma unroll
                for (int m = 0; m < 4; ++m) { int rowi = row0 + ai * 128 + m * 16; asm volatile("" : "+v"(rowi) :: "memory");
                    f32x4 y[2][2] = {{acc[ai][0][m][0], acc[ai][0][m][1]}, {acc[ai][1][m][0], acc[ai][1][m][1]}};
                    float ss = 0.f;
#pragma unroll
                    for (int a_ = 0; a_ < 2; ++a_)
#pragma unroll
                        for (int b_ = 0; b_ < 2; ++b_) ss += (y[a_][b_][0] * y[a_][b_][0] + y[a_][b_][1] * y[a_][b_][1]) + (y[a_][b_][2] * y[a_][b_][2] + y[a_][b_][3] * y[a_][b_][3]);
                    ss += __shfl_xor(ss, 16); ss += __shfl_xor(ss, 32);
                    const float rs = 1.0f / sqrtf(ss * (1.0f / 64.0f) + EPS);
                    y[0][0] = y[0][0] * rs * g00; y[0][1] = y[0][1] * rs * g01; y[1][0] = y[1][0] * rs * g10; y[1][1] = y[1][1] * rs * g11;
                    int b, n, Nq, Nk, koff; size_t base;
                    if (!smp) { b = rowi >> 8; n = rowi & 255; Nq = PSEQ; Nk = PSEQ; koff = 0; base = 0; }
                    else { const int r2 = rowi - NPROMPT; b = r2 >> 12; n = r2 & 4095; Nq = SSEQ; Nk = SNK; koff = PAST; base = (size_t)PB * 16 * PSEQ * 64; }
                    if (smp) {
                        const float* tr = RT + (n >> 6) * 16 + jb; const float* tc = RT + (n & 63) * 16 + jb;
#pragma unroll
                        for (int a_ = 0; a_ < 2; ++a_) { const float* tp = a_ ? tc : tr;
#pragma unroll
                            for (int b_ = 0; b_ < 2; ++b_) { const f32x4 c4 = *(const f32x4*)(tp + 4 * b_), s4 = *(const f32x4*)(tp + 1024 + 4 * b_);
#pragma unroll
                                for (int j = 0; j < 4; ++j) { const float pr = __shfl_xor(y[a_][b_][j], 32); y[a_][b_][j] = isx2 ? (y[a_][b_][j] * c4[j] + pr * s4[j]) : (y[a_][b_][j] * c4[j] - pr * s4[j]); } } }
                    }
                    if (isq) { bf16_t* dst = QN + base + ((size_t)(b * 16 + hc) * Nq + n) * 64 + 8 * fq;
#pragma unroll
                        for (int a_ = 0; a_ < 2; ++a_) { const f32x4 v0 = y[a_][0] * QSCALE, v1 = y[a_][1] * QSCALE;
                            u32x4 w; w.x = cvtpk(v0[0], v0[1]); w.y = cvtpk(v0[2], v0[3]); w.z = cvtpk(v1[0], v1[1]); w.w = cvtpk(v1[2], v1[3]); *(u32x4*)(dst + 32 * a_) = w; } }
                    else { bf16_t* dst = KC + base + ((size_t)(b * 16 + hc) * Nk + koff + n) * 64 + 8 * fq;
#pragma unroll
                        for (int a_ = 0; a_ < 2; ++a_) { const f32x4 v0 = y[a_][0], v1 = y[a_][1];
                            u32x4 w; w.x = cvtpk(v0[0], v0[1]); w.y = cvtpk(v0[2], v0[3]); w.z = cvtpk(v1[0], v1[1]); w.w = cvtpk(v1[2], v1[3]); *(u32x4*)(dst + 32 * a_) = w; }
                        if (!smp) { float* o = ock + ((size_t)(b * DEPTH + l) * PSEQ + n) * 1024 + hc * 64 + 8 * fq;
#pragma unroll
                            for (int a_ = 0; a_ < 2; ++a_) { *(f32x4*)(o + 32 * a_) = y[a_][0]; *(f32x4*)(o + 32 * a_ + 4) = y[a_][1]; } } }
                    asm volatile("" ::: "memory"); }
            return;
        }
        const int mode = (pn < 4) ? 0 : (pn < 8) ? 1 : (pn < 20) ? 0 : (pn < 24) ? 1 : 2;
        const int col0 = u.c0 + wc * 64 + 8 * fq;
        const bool native = (pn >= 4 && pn < 8) || pn >= 24;
        unsigned char* nbase = (pn >= 24) ? GN + nat_off((u.r0 >> 8) * 16 + (pn - 24), 0, 0, 0, wr * 4 + wc, 0) : ZN + nat_off((u.r0 >> 8) * 4 + (pn - 4), 0, 0, 0, wr * 4 + wc, 0);
#pragma unroll
        for (int ai = 0; ai < 2; ++ai)
#pragma unroll
            for (int m = 0; m < 4; ++m) { int rowi = row0 + ai * 128 + m * 16; asm volatile("" : "+v"(rowi) :: "memory"); bf16_t* rowp = P + (size_t)rowi * INC + col0;
#pragma unroll
                for (int bj = 0; bj < 2; ++bj) { f32x4 v0 = acc[ai][bj][m][0], v1 = acc[ai][bj][m][1];
                    if (mode == 1) {
#pragma unroll
                        for (int j = 0; j < 4; ++j) { v0[j] = siluf_(v0[j]); v1[j] = siluf_(v1[j]); } }
                    else if (mode == 2) {
#pragma unroll
                        for (int j = 0; j < 4; ++j) { v0[j] = sigmoidf_(v0[j]); v1[j] = sigmoidf_(v1[j]); } }
                    u32x4 w; w.x = cvtpk(v0[0], v0[1]); w.y = cvtpk(v0[2], v0[3]); w.z = cvtpk(v1[0], v1[1]); w.w = cvtpk(v1[2], v1[3]);
                    if (native) { unsigned vo = (unsigned)(fr + 16 * fq) * 16u; asm volatile("" : "+v"(vo)); __builtin_nontemporal_store(w, (u32x4*)(nbase + (size_t)((ai * 4 + m) * 2 + bj) * 8192 + vo)); } else __builtin_nontemporal_store(w, (u32x4*)(rowp + bj * 32)); }
                asm volatile("" ::: "memory"); }
    }
};
struct EpiStore {
    static constexpr bool PERM = true, HAS_MID = false, PROBE2 = false, CH64 = false;
    bf16_t* O;
    __device__ __forceinline__ void operator()(const f32x4 (&acc)[2][2][4][2], const Unit& u, int wr, int wc, int fr, int fq) const {
        bf16_t* base = O + u.co + (size_t)(wr * 64 + fr) * u.ldc + wc * 32 + 8 * fq;
#pragma unroll
        for (int ai = 0; ai < 2; ++ai)
#pragma unroll
            for (int m = 0; m < 4; ++m) { int rowi = ai * 128 + m * 16; asm volatile("" : "+v"(rowi) :: "memory"); bf16_t* rowp = base + (size_t)rowi * u.ldc;
#pragma unroll
                for (int bj = 0; bj < 2; ++bj) { const f32x4 v0 = acc[ai][bj][m][0], v1 = acc[ai][bj][m][1];
                    u32x4 w; w.x = cvtpk(v0[0], v0[1]); w.y = cvtpk(v0[2], v0[3]); w.z = cvtpk(v1[0], v1[1]); w.w = cvtpk(v1[2], v1[3]);
                    *(u32x4*)(rowp + bj * 128) = w; }
                asm volatile("" ::: "memory"); }
    }
};
struct EpiPos {
    static constexpr bool PERM = true, HAS_MID = false, PROBE2 = false, CH64 = true;
    const unsigned char* ZN; bf16_t* Y;
    __device__ __forceinline__ void operator()(const f32x4 (&acc)[2][2][4][2], const Unit& u, int wr, int wc, int fr, int fq) const {
        const int row0 = u.r0 + wr * 64 + fr, col0 = u.c0 + wc * 64 + 8 * fq;
        const unsigned char* nb = ZN + nat_off((u.r0 >> 8) * 4 + (u.c0 >> 8), 0, 0, 0, wr * 4 + wc, 0);
#pragma unroll
        for (int ai = 0; ai < 2; ++ai)
#pragma unroll
            for (int m = 0; m < 4; ++m) { int rowi = row0 + ai * 128 + m * 16; asm volatile("" : "+v"(rowi) :: "memory"); const size_t row = (size_t)rowi;
#pragma unroll
                for (int bj = 0; bj < 2; ++bj) { const f32x4 v0 = acc[ai][bj][m][0], v1 = acc[ai][bj][m][1];
                    unsigned vo = (unsigned)(fr + 16 * fq) * 16u; asm volatile("" : "+v"(vo)); const u32x4 z = *(const u32x4*)(nb + (size_t)((ai * 4 + m) * 2 + bj) * 8192 + vo); float zf[8]; unpack8(z, zf);
                    u32x4 w; w.x = cvtpk(v0[0] * zf[0], v0[1] * zf[1]); w.y = cvtpk(v0[2] * zf[2], v0[3] * zf[3]); w.z = cvtpk(v1[0] * zf[4], v1[1] * zf[5]); w.w = cvtpk(v1[2] * zf[6], v1[3] * zf[7]);
                    *(u32x4*)(Y + row * D + col0 + bj * 32) = w; }
                asm volatile("" ::: "memory"); }
    }
};
struct EpiMerge {
    static constexpr bool PERM = true, HAS_MID = true, PROBE2 = false, CH64 = true;
    const unsigned char* GN; bf16_t* MG;
    __device__ __forceinline__ void mid(f32x4 (&acc)[2][2][4][2], const Unit& u, int wr, int wc, int fr, int fq) const {
        const unsigned char* gfb = GN + nat_off((u.r0 >> 8) * 16 + (u.c0 >> 8), 0, 0, 0, wr * 4 + wc, 0); const unsigned char* gab = gfb + (size_t)8 * 131072;
#pragma unroll
        for (int ai = 0; ai < 2; ++ai) {
            unsigned vo = (unsigned)(fr + 16 * fq) * 16u; asm volatile("" : "+v"(vo) :: "memory");
            u32x4 ra[4][2], rb[4][2];
#pragma unroll
            for (int m = 0; m < 4; ++m)
#pragma unroll
                for (int bj = 0; bj < 2; ++bj) { const size_t o = (size_t)((ai * 4 + m) * 2 + bj) * 8192; ra[m][bj] = *(const u32x4*)(gfb + o + vo); rb[m][bj] = *(const u32x4*)(gab + o + vo); }
            __builtin_amdgcn_sched_barrier(0);
#pragma unroll
            for (int m = 0; m < 4; ++m)
#pragma unroll
                for (int bj = 0; bj < 2; ++bj) { float gf[8], ga[8]; unpack8(ra[m][bj], gf); unpack8(rb[m][bj], ga);
#pragma unroll
                    for (int j = 0; j < 4; ++j) { acc[ai][bj][m][0][j] *= gf[j] * __builtin_amdgcn_rcpf(ga[j]); acc[ai][bj][m][1][j] *= gf[4 + j] * __builtin_amdgcn_rcpf(ga[4 + j]); } }
            asm volatile("" ::: "memory"); }
    }
    __device__ __forceinline__ void operator()(const f32x4 (&acc)[2][2][4][2], const Unit& u, int wr, int wc, int fr, int fq) const {
        const int row0 = u.r0 + wr * 64 + fr, col0 = u.c0 + wc * 64 + 8 * fq;
        const unsigned char* gab = GN + nat_off((u.r0 >> 8) * 16 + 8 + (u.c0 >> 8), 0, 0, 0, wr * 4 + wc, 0);
#pragma unroll
        for (int ai = 0; ai < 2; ++ai)
#pragma unroll
            for (int m = 0; m < 4; ++m) { int rowi = row0 + ai * 128 + m * 16; asm volatile("" : "+v"(rowi) :: "memory"); const size_t row = (size_t)rowi;
#pragma unroll
                for (int bj = 0; bj < 2; ++bj) { const f32x4 v0 = acc[ai][bj][m][0], v1 = acc[ai][bj][m][1];
                    unsigned vo = (unsigned)(fr + 16 * fq) * 16u; asm volatile("" : "+v"(vo)); const u32x4 b = *(const u32x4*)(gab + (size_t)((ai * 4 + m) * 2 + bj) * 8192 + vo); float ga[8]; unpack8(b, ga);
                    u32x4 w; w.x = cvtpk(v0[0] * ga[0], v0[1] * ga[1]); w.y = cvtpk(v0[2] * ga[2], v0[3] * ga[3]); w.z = cvtpk(v1[0] * ga[4], v1[1] * ga[5]); w.w = cvtpk(v1[2] * ga[6], v1[3] * ga[7]);
                    *(u32x4*)(MG + row * D + col0 + bj * 32) = w; }
                asm volatile("" ::: "memory"); }
    }
};
struct EpiOut {
    static constexpr bool PERM = false, HAS_MID = false, PROBE2 = false, CH64 = false;
    const float* xp; const float* xs; float* out; const float* mod;
    __device__ __forceinline__ void operator()(const f32x4 (&acc)[2][2][4][2], const Unit& u, int wr, int wc, int fr, int fq) const {
        const int row0 = u.r0 + wr * 64 + fr, col0 = u.c0 + wc * 32 + 4 * fq;
        const int cv = (u.r0 < NPROMPT) ? 0 : 1 + ((u.r0 - NPROMPT) >> 12);
        const float* gate = mod + cv * 6144 + 4096 + col0;
        const float* xin = (u.r0 < NPROMPT) ? xp : xs - (size_t)NPROMPT * D;
        f32x4 gv[2][2];
#pragma unroll
        for (int bj = 0; bj < 2; ++bj)
#pragma unroll
            for (int n = 0; n < 2; ++n) gv[bj][n] = *(const f32x4*)(gate + bj * 128 + n * 16);
        f32x4 xn[2][2];
        { int rowi = row0; asm volatile("" : "+v"(rowi) :: "memory"); const size_t off = (size_t)rowi * D + col0;
#pragma unroll
          for (int bj = 0; bj < 2; ++bj)
#pragma unroll
              for (int n = 0; n < 2; ++n) xn[bj][n] = *(const f32x4*)(xin + off + bj * 128 + n * 16); }
#pragma unroll
        for (int g = 0; g < 8; ++g) { const int ai = g >> 2, m = g & 3;
            f32x4 xo[2][2];
#pragma unroll
            for (int bj = 0; bj < 2; ++bj)
#pragma unroll
                for (int n = 0; n < 2; ++n) xo[bj][n] = xn[bj][n];
            if (g < 7) { int rowi = row0 + ((g + 1) >> 2) * 128 + ((g + 1) & 3) * 16; asm volatile("" : "+v"(rowi)); const size_t off = (size_t)rowi * D + col0;
#pragma unroll
                for (int bj = 0; bj < 2; ++bj)
#pragma unroll
                    for (int n = 0; n < 2; ++n) xn[bj][n] = *(const f32x4*)(xin + off + bj * 128 + n * 16); }
            __builtin_amdgcn_sched_barrier(0);
            { int rowi = row0 + ai * 128 + m * 16; asm volatile("" : "+v"(rowi)); const size_t off = (size_t)rowi * D + col0;
#pragma unroll
              for (int bj = 0; bj < 2; ++bj)
#pragma unroll
                  for (int n = 0; n < 2; ++n) *(f32x4*)(out + off + bj * 128 + n * 16) = xo[bj][n] + gv[bj][n] * acc[ai][bj][m][n]; }
            __builtin_amdgcn_sched_barrier(0); }
        asm volatile("" ::: "memory");
    }
};

struct MapChan {
    const char* CST; const char* P;
    __device__ __forceinline__ void operator()(int L, Unit& u) const {
        int b, g, pm, pn, N1, tok0; size_t abt;
        if (L < 128) { b = L >> 3; g = (L >> 1) & 3; pm = L & 1; pn = 0; N1 = PSEQ; tok0 = b * PSEQ; abt = (size_t)b * 1024 * 512; }
        else { const int M_ = L - 128; b = M_ >> 7; g = (M_ >> 5) & 3; pm = (M_ >> 4) & 1; pn = M_ & 15; N1 = SSEQ; tok0 = NPROMPT + b * SSEQ; abt = (size_t)PB * 1024 * 512 + (size_t)b * 1024 * 8192; }
        u.aP = CST + (size_t)pm * 256 * 256 * 2;
        u.bP = P + ((size_t)(tok0 + pn * 256) * INC + C_UF + g * 256) * 2;
        u.co = abt + (size_t)(g * 256) * (2 * N1) + (size_t)pm * N1 + pn * 256; u.ldc = 2 * N1; u.r0 = 0; u.c0 = 0;
    }
};
struct MapPosP {
    const char* T; const char* ABT;
    __device__ __forceinline__ void operator()(int L, Unit& u) const {
        const int b = L >> 2, pn = L & 3;
        u.aP = T; u.bP = ABT + ((size_t)b * 1024 * 512 + (size_t)pn * 256 * 512) * 2; u.r0 = b * PSEQ; u.c0 = pn * 256; u.co = 0; u.ldc = 0;
    }
};
struct MapPosS {
    const char* T; const char* FB;
    __device__ __forceinline__ void operator()(int L, Unit& u) const {
        const int b = L >> 6, pm = (L >> 2) & 15, pn = L & 3;
        u.aP = T + (size_t)pm * 256 * 4096 * 2; u.bP = FB + ((size_t)b * 1024 * 4096 + (size_t)pn * 256 * 4096) * 2;
        u.r0 = NPROMPT + b * SSEQ + pm * 256; u.c0 = pn * 256; u.co = 0; u.ldc = 0;
    }
};

struct Args {
    const float* in[20]; float* out; unsigned char* ws; int ph_lo, ph_hi;
};

__device__ __forceinline__ void transpose_item(const float* W, int N, bf16_t* WT, int ldwt, int koff, LAS float* scr, int item, int lane) {
    const int nblk = N / 32, kb = item / nblk, nb = item % nblk, k0 = 64 * kb, n0 = 32 * nb;
#pragma unroll 8
    for (int i = 0; i < 32; ++i) { const int kk = 2 * i + (lane >> 5); scr[kk * 33 + (lane & 31)] = W[(size_t)(k0 + kk) * N + n0 + (lane & 31)]; }
    asm volatile("s_waitcnt lgkmcnt(0)" ::: "memory");
    const int c = lane & 7;
#pragma unroll
    for (int j = 0; j < 4; ++j) { const int n = (lane >> 3) + 8 * j; const LAS float* s = scr + (8 * c) * 33 + n;
        u32x4 o; o.x = cvtpk(s[0 * 33], s[1 * 33]); o.y = cvtpk(s[2 * 33], s[3 * 33]); o.z = cvtpk(s[4 * 33], s[5 * 33]); o.w = cvtpk(s[6 * 33], s[7 * 33]);
        *(u32x4*)(WT + (size_t)(n0 + n) * ldwt + koff + k0 + 8 * c) = o; }
    asm volatile("s_waitcnt lgkmcnt(0)" ::: "memory");
}

__device__ __forceinline__ void phase_pre0(const Args& a, LAS unsigned char* lds) {
    const int tid = threadIdx.x, lane = tid & 63, wave = __builtin_amdgcn_readfirstlane(tid >> 6), G = gridDim.x;
    unsigned char* ws = a.ws;
    {
        LAS float* scr = (LAS float*)(lds + wave * 16384);
        const int gw = blockIdx.x * 8 + wave, NGW = G * 8;
        constexpr int I_IN = 4 * 32 * 320, I_F = 4 * 16 * 64, I_O = 4 * 32 * 64, NIT = I_IN + 2 * I_F + I_O;
        bf16_t* WIN = (bf16_t*)(ws + WS_WIN); bf16_t* WM = (bf16_t*)(ws + WS_WM); bf16_t* WO = (bf16_t*)(ws + WS_WO);
        for (int it = gw; it < NIT; it += NGW) {
            int r = it;
            if (r < I_IN) { const int l = r / 10240, rr = r % 10240; transpose_item(a.in[6] + (size_t)l * D * INC, INC, WIN + (size_t)l * INC * D, D, 0, scr, rr, lane); continue; } r -= I_IN;
            if (r < I_F) { const int l = r / 1024, rr = r % 1024; transpose_item(a.in[7] + (size_t)l * 1024 * D, D, WM + (size_t)l * D * D, D, 0, scr, rr, lane); continue; } r -= I_F;
            if (r < I_F) { const int l = r / 1024, rr = r % 1024; transpose_item(a.in[8] + (size_t)l * 1024 * D, D, WM + (size_t)l * D * D, D, 1024, scr, rr, lane); continue; } r -= I_F;
            { const int l = r / 2048, rr = r % 2048; transpose_item(a.in[9] + (size_t)l * D * D, D, WO + (size_t)l * D * D, D, 0, scr, rr, lane); }
        }
    }
    __syncthreads();
    {
        LAS float* sc = (LAS float*)lds;
        float* MODP = (float*)(ws + WS_MODP);
        const float* wmod = a.in[10];
        for (int un = blockIdx.x; un < 768; un += G) {
            const int l = un / 192, part = (un / 12) % 16, jb = un % 12, j = jb * 512 + tid;
            __syncthreads();
            for (int idx = tid; idx < 640; idx += 512) { const int c = idx >> 7, i = idx & 127;
                const float v = (c == 0) ? a.in[5][part * 128 + i] : a.in[2][(c - 1) * D + part * 128 + i]; sc[idx] = siluf_(v); }
            __syncthreads();
            float s0 = 0.f, s1 = 0.f, s2 = 0.f, s3 = 0.f, s4 = 0.f;
            const float* wp = wmod + ((size_t)l * D + part * 128) * 6144 + j;
#pragma unroll 8
            for (int i = 0; i < 128; ++i) { const float w = wp[(size_t)i * 6144]; s0 += sc[i] * w; s1 += sc[128 + i] * w; s2 += sc[256 + i] * w; s3 += sc[384 + i] * w; s4 += sc[512 + i] * w; }
            float* o = MODP + ((size_t)(l * 16 + part) * 5) * 6144 + j;
            o[0] = s0; o[6144] = s1; o[2 * 6144] = s2; o[3 * 6144] = s3; o[4 * 6144] = s4;
        }
    }
    {
        const size_t gt = (size_t)blockIdx.x * 512 + tid, NT_ = (size_t)G * 512;
        bf16_t* T4 = (bf16_t*)(ws + WS_T4096); bf16_t* T2 = (bf16_t*)(ws + WS_TAB); bf16_t* CS = (bf16_t*)(ws + WS_TAB + 256 * 1024);
        for (size_t ch = gt; ch < (size_t)4096 * 512; ch += NT_) {
            const int k1 = (int)(ch >> 9), kk0 = (int)(ch & 511) * 8; float v[8];
#pragma unroll
            for (int e = 0; e < 8; ++e) { const int kk = kk0 + e, n1 = (kk <= 2048) ? kk : kk - 2048; const float fr_ = (float)((k1 * n1) & 4095) * (1.0f / 4096.0f);
                v[e] = (kk <= 2048) ? __builtin_amdgcn_cosf(fr_) * (1.0f / 64.0f) : -__builtin_amdgcn_sinf(fr_) * (1.0f / 64.0f); }
            u32x4 o; o.x = cvtpk(v[0], v[1]); o.y = cvtpk(v[2], v[3]); o.z = cvtpk(v[4], v[5]); o.w = cvtpk(v[6], v[7]);
            *(u32x4*)(T4 + ch * 8) = o;
        }
        for (size_t ch = gt; ch < (size_t)256 * 64; ch += NT_) {
            const int k1 = (int)(ch >> 6), kk0 = (int)(ch & 63) * 8; float v[8];
#pragma unroll
            for (int e = 0; e < 8; ++e) { const int kk = kk0 + e, n1 = kk & 255; const float fr_ = (float)((k1 * n1) & 255) * (1.0f / 256.0f);
                v[e] = (kk < 256) ? __builtin_amdgcn_cosf(fr_) * (1.0f / 16.0f) : -__builtin_amdgcn_sinf(fr_) * (1.0f / 16.0f); }
            u32x4 o; o.x = cvtpk(v[0], v[1]); o.y = cvtpk(v[2], v[3]); o.z = cvtpk(v[4], v[5]); o.w = cvtpk(v[6], v[7]);
            *(u32x4*)(T2 + ch * 8) = o;
        }
        for (size_t ch = gt; ch < (size_t)512 * 32; ch += NT_) {
            const int m = (int)(ch >> 5), c0 = (int)(ch & 31) * 8, k2 = m & 255; float v[8];
#pragma unroll
            for (int e = 0; e < 8; ++e) { const float fr_ = (float)((k2 * (c0 + e)) & 255) * (1.0f / 256.0f);
                v[e] = (m < 256) ? __builtin_amdgcn_cosf(fr_) * (1.0f / 16.0f) : __builtin_amdgcn_sinf(fr_) * (1.0f / 16.0f); }
            u32x4 o; o.x = cvtpk(v[0], v[1]); o.y = cvtpk(v[2], v[3]); o.z = cvtpk(v[4], v[5]); o.w = cvtpk(v[6], v[7]);
            *(u32x4*)(CS + ch * 8) = o;
        }
        float* RT = (float*)(ws + WS_TAB + 512 * 1024);
        if (gt < 1024) { const int pos = (int)(gt >> 4), j = (int)(gt & 15); float sn_, cs_; sincosf((float)pos * exp2f(-(float)j * (13.287712379549449f / 16.0f)), &sn_, &cs_); RT[gt] = cs_; RT[1024 + gt] = sn_; }
    }
}
__device__ __forceinline__ void phase_pre1(const Args& a) {
    const size_t gt = (size_t)blockIdx.x * 512 + threadIdx.x, NT_ = (size_t)gridDim.x * 512;
    const float* MODP = (const float*)(a.ws + WS_MODP); float* MOD = (float*)(a.ws + WS_MOD);
    for (size_t idx = gt; idx < (size_t)4 * 5 * 6144; idx += NT_) {
        const int l = (int)(idx / 30720), c = (int)((idx / 6144) % 5), j = (int)(idx % 6144);
        float s = a.in[11][l * 6144 + j];
#pragma unroll
        for (int p = 0; p < 16; ++p) s += MODP[((size_t)(l * 16 + p) * 5 + c) * 6144 + j];
        MOD[idx] = s;
    }
    if (gt < 4) { const int l = (int)gt; float s1 = 0.f, s2 = 0.f;
        for (int i = 0; i < 64; ++i) { s1 += a.in[16][l * 64 + i] * a.in[17][l * 64 + i]; s2 += a.in[18][l * 64 + i] * a.in[19][l * 64 + i]; }
        const float lam_init = 0.8f - 0.6f * expf(-0.3f * (float)l);
        MOD[4 * 5 * 6144 + l] = expf(s1) - expf(s2) + lam_init; }
}
__device__ __forceinline__ void phase_norm(const Args& a, int l) {
    int tid_ = threadIdx.x; asm volatile("" : "+v"(tid_));
    const int tid = tid_, lane = tid & 63, wave = tid >> 6, G = gridDim.x;
    const int gw = blockIdx.x * 8 + wave, NGW = G * 8;
    const float* MOD = (const float*)(a.ws + WS_MOD) + (size_t)l * 5 * 6144;
    const float* gn = a.in[12] + l * D;
    bf16_t* H = (bf16_t*)(a.ws + WS_H);
    for (int row = gw; row < NTOK; row += NGW) {
        const float* xrow = (l == 0) ? ((row < NPROMPT) ? a.in[0] + (size_t)row * D : a.in[1] + (size_t)(row - NPROMPT) * D) : a.out + (size_t)row * D;
        const int cv = (row < NPROMPT) ? 0 : 1 + ((row - NPROMPT) >> 12);
        const f32x4* xr = (const f32x4*)xrow + lane;
        f32x4 v[8]; float ss = 0.f;
#pragma unroll
        for (int j = 0; j < 8; ++j) { v[j] = xr[64 * j]; ss += (v[j].x * v[j].x + v[j].y * v[j].y) + (v[j].z * v[j].z + v[j].w * v[j].w); }
        const float rstd = 1.0f / sqrtf(wave_sum(ss) * (1.0f / D) + EPS);
        const float* sh = MOD + cv * 6144; const float* sc = sh + 2048;
#pragma unroll
        for (int j = 0; j < 8; ++j) { const int idx = (lane + 64 * j) * 4;
            const f32x4 g4 = *(const f32x4*)(gn + idx), s4 = *(const f32x4*)(sc + idx), h4 = *(const f32x4*)(sh + idx);
            const f32x4 o = v[j] * rstd * g4 * (s4 + 1.0f) + h4;
            u32x2 w; w.x = cvtpk(o.x, o.y); w.y = cvtpk(o.z, o.w);
            *(u32x2*)(H + (size_t)row * D + idx) = w; }
    }
    const size_t gt = (size_t)blockIdx.x * 512 + tid, NT_ = (size_t)G * 512;
    bf16_t* KCs = (bf16_t*)(a.ws + WS_KC) + (size_t)PB * 8 * 2 * PSEQ * 64;
    bf16_t* VTs = (bf16_t*)(a.ws + WS_VT) + (size_t)PB * 8 * 128 * PSEQ;
    for (size_t ch = gt; ch < (size_t)SB * PAST * 128; ch += NT_) {
        const int c8 = (int)(ch & 7), hc = (int)((ch >> 3) & 15), key = (int)((ch >> 7) & 511), b = (int)(ch >> 16);
        const float* src = a.in[3] + (((size_t)(b * DEPTH + l) * PAST + key) * 1024 + hc * 64 + c8 * 8);
        const f32x4 x0 = *(const f32x4*)src, x1 = *(const f32x4*)(src + 4);
        u32x4 w; w.x = cvtpk(x0.x, x0.y); w.y = cvtpk(x0.z, x0.w); w.z = cvtpk(x1.x, x1.y); w.w = cvtpk(x1.z, x1.w);
        *(u32x4*)(KCs + (((size_t)(b * 16 + hc)) * SNK + key) * 64 + c8 * 8) = w;
    }
    for (size_t ch = gt; ch < (size_t)SB * 8 * 64 * 32; ch += NT_) {
        const int d4 = (int)(ch & 31) * 4, pc = (int)((ch >> 5) & 63), h = (int)((ch >> 11) & 7), b = (int)(ch >> 14);
        const int s_ = pc >> 1, hf = pc & 1; f32x4 x[8];
#pragma unroll
        for (int i = 0; i < 8; ++i) { const int key = 16 * s_ + 8 * (i >> 2) + 4 * hf + (i & 3);
            x[i] = *(const f32x4*)(a.in[4] + ((size_t)(b * DEPTH + l) * PAST + key) * 1024 + h * 128 + d4); }
#pragma unroll
        for (int j = 0; j < 4; ++j) { u32x4 w; w.x = cvtpk(x[0][j], x[1][j]); w.y = cvtpk(x[2][j], x[3][j]); w.z = cvtpk(x[4][j], x[5][j]); w.w = cvtpk(x[6][j], x[7][j]);
            *(u32x4*)(VTs + ((size_t)(b * 8 + h) * 128 + d4 + j) * SNK + pc * 8) = w; }
    }
}
__device__ __forceinline__ void phase_prep(const Args& a, int l, LAS unsigned char* lds) {
    int tid_ = threadIdx.x; asm volatile("" : "+v"(tid_));
    const int tid = tid_, lane = tid & 63, wave = tid >> 6, G = gridDim.x;
    const int gw = blockIdx.x * 8 + wave, NGW = G * 8;
    const bf16_t* P = (const bf16_t*)(a.ws + WS_P);
    bf16_t* QN = (bf16_t*)(a.ws + WS_QN); bf16_t* KC = (bf16_t*)(a.ws + WS_KC); bf16_t* VT = (bf16_t*)(a.ws + WS_VT);
    float* ock = a.out + (size_t)41943040; float* ocv = a.out + (size_t)58720256;
    for (int item = blockIdx.x; item < 2560; item += G) {
        const int tb = item >> 3, h = item & 7, tok0 = tb * 64;
        const bool smp = tok0 >= NPROMPT;
        int b, n0, Nk, koff; size_t vbase;
        if (!smp) { b = tok0 >> 8; n0 = tok0 & 255; Nk = PSEQ; koff = 0; vbase = 0; }
        else { const int r2 = tok0 - NPROMPT; b = r2 >> 12; n0 = r2 & 4095; Nk = SNK; koff = PAST; vbase = (size_t)PB * 8 * 128 * PSEQ; }
        __syncthreads();
#pragma unroll
        for (int i = 0; i < 2; ++i) { const int piece = tid + 512 * i, r = piece >> 4, cc = piece & 15;
            const u32x4 v = *(const u32x4*)(P + (size_t)(tok0 + r) * INC + C_V + h * 128 + cc * 8);
            *(LAS u32x4*)(lds + r * 272 + cc * 16) = v;
            if (!smp) { float f[8]; unpack8(v, f); float* o = ocv + ((size_t)(b * DEPTH + l) * PSEQ + n0 + r) * 1024 + h * 128 + cc * 8;
                *(f32x4*)o = (f32x4){f[0], f[1], f[2], f[3]}; *(f32x4*)(o + 4) = (f32x4){f[4], f[5], f[6], f[7]}; } }
        __syncthreads();
        { const int dp = tid >> 3, d = 2 * dp, pc = tid & 7, s_ = pc >> 1, hf = pc & 1;
            unsigned e[8];
#pragma unroll
            for (int j = 0; j < 8; ++j) { const int key = 16 * s_ + 8 * (j >> 2) + 4 * hf + (j & 3); e[j] = *(const LAS unsigned*)(lds + key * 272 + d * 2); }
            u32x4 w0, w1;
            w0.x = (e[0] & 0xffffu) | (e[1] << 16); w0.y = (e[2] & 0xffffu) | (e[3] << 16); w0.z = (e[4] & 0xffffu) | (e[5] << 16); w0.w = (e[6] & 0xffffu) | (e[7] << 16);
            w1.x = (e[0] >> 16) | (e[1] & 0xffff0000u); w1.y = (e[2] >> 16) | (e[3] & 0xffff0000u); w1.z = (e[4] >> 16) | (e[5] & 0xffff0000u); w1.w = (e[6] >> 16) | (e[7] & 0xffff0000u);
            bf16_t* dst = VT + vbase + ((size_t)(b * 8 + h) * 128 + d) * Nk + koff + n0 + pc * 8;
            *(u32x4*)dst = w0; *(u32x4*)(dst + Nk) = w1; }
    }
    __syncthreads();
}

__device__ __forceinline__ void phase_fold(const Args& a) {
    int tid_ = threadIdx.x; asm volatile("" : "+v"(tid_));
    const size_t gt = (size_t)blockIdx.x * 512 + tid_, NT_ = (size_t)gridDim.x * 512;
    const bf16_t* ABTs = (const bf16_t*)(a.ws + WS_ABT) + (size_t)PB * 1024 * 512;
    bf16_t* FB = (bf16_t*)(a.ws + WS_T4096 + 32 * MiB);
    for (size_t ch = gt; ch < (size_t)SB * 1024 * 512; ch += NT_) {
        const int kk0 = (int)(ch & 511) * 8; const size_t row = ch >> 9;
        const bf16_t* A = ABTs + row * 8192; const bf16_t* B = A + 4096;
        const bool apart = kk0 < 2048; const bf16_t* X = apart ? A : B; const int f0 = apart ? kk0 : kk0 - 2048;
        float fw[8], mr[8]; unpack8(*(const u32x4*)(X + f0), fw); unpack8(*(const u32x4*)(X + 4096 - f0 - 8), mr);
        const float m0 = (f0 > 0) ? bf2f(X[4096 - f0]) : 0.f;
        float v[8];
        if (apart) { v[0] = (f0 == 0) ? fw[0] : fw[0] + m0;
#pragma unroll
            for (int e = 1; e < 8; ++e) v[e] = fw[e] + mr[8 - e]; }
        else { v[0] = (f0 == 0) ? bf2f(A[2048]) : fw[0] - m0;
#pragma unroll
            for (int e = 1; e < 8; ++e) v[e] = fw[e] - mr[8 - e]; }
        u32x4 o; o.x = cvtpk(v[0], v[1]); o.y = cvtpk(v[2], v[3]); o.z = cvtpk(v[4], v[5]); o.w = cvtpk(v[6], v[7]);
        *(u32x4*)(FB + row * 4096 + kk0) = o;
    }
}

__device__ __forceinline__ void attn_item(LAS unsigned char* lds, const bf16_t* Q, int Nq, const bf16_t* Kc, const bf16_t* Vt, int Nk, int q0,
                                          float lam, float onorm, const float* gsub, const bf16_t* za, bf16_t* Yo) {
    int tid_ = threadIdx.x; asm volatile("" : "+v"(tid_));
    const int tid = tid_, lane = tid & 63, wave = __builtin_amdgcn_readfirstlane(tid >> 6), r32 = lane & 31, hi = lane >> 5, c = wave >> 2, qs = wave & 3;
    bf16x8 qr[4];
    { const bf16_t* qp = Q + ((size_t)c * Nq + q0 + qs * 32 + r32) * 64 + hi * 8;
#pragma unroll
      for (int d0 = 0; d0 < 4; ++d0) qr[d0] = *(const bf16x8*)(qp + d0 * 16); }
    const int srow = wave * 8 + (lane >> 3), sch = (lane & 7) ^ ((srow >> 1) & 7);
    const bf16_t* k0src = Kc + (size_t)srow * 64 + sch * 8; const bf16_t* k1src = k0src + (size_t)Nk * 64;
    const bf16_t* v0src = Vt + (size_t)srow * Nk + sch * 8; const bf16_t* v1src = v0src + (size_t)64 * Nk;
    const int wpiece = wave * 1024;
#define ATT_DMA(stgoff, tt) do { \
        __builtin_amdgcn_global_load_lds((const unsigned*)(k0src + (size_t)(tt) * 4096), (LAS unsigned*)(lds + (stgoff) + wpiece), 16, 0, 0); \
        __builtin_amdgcn_global_load_lds((const unsigned*)(k1src + (size_t)(tt) * 4096), (LAS unsigned*)(lds + (stgoff) + 8192 + wpiece), 16, 0, 0); \
        __builtin_amdgcn_global_load_lds((const unsigned*)(v0src + (size_t)(tt) * 64), (LAS unsigned*)(lds + (stgoff) + 16384 + wpiece), 16, 0, 0); \
        __builtin_amdgcn_global_load_lds((const unsigned*)(v1src + (size_t)(tt) * 64), (LAS unsigned*)(lds + (stgoff) + 24576 + wpiece), 16, 0, 0); } while (0)
    const int swz = (r32 >> 1) & 7; int xo[4];
#pragma unroll
    for (int j = 0; j < 4; ++j) xo[j] = ((2 * j + hi) ^ swz) * 16;
    const int kro = c * 8192 + r32 * 128, vro = 16384 + r32 * 128;
    const int NT = Nk >> 6;
    ATT_DMA(0, 0);
    __syncthreads();
    f32x16 O[4];
#pragma unroll
    for (int i = 0; i < 4; ++i)
#pragma unroll
        for (int r = 0; r < 16; ++r) O[i][r] = 0.f;
    f32x16 negm;
#pragma unroll
    for (int r = 0; r < 16; ++r) negm[r] = 0.f;
    float m = 0.f, lsum = 0.f;
    bf16x8 pf[4];
#pragma unroll
    for (int i = 0; i < 4; ++i) pf[i] = (bf16x8){0, 0, 0, 0, 0, 0, 0, 0};
#define ATT_VLD(dst, stg, db) do { _Pragma("unroll") for (int i_ = 0; i_ < 4; ++i_) dst[i_] = *(const LAS bf16x8*)((stg) + vro + (db) * 4096 + xo[i_]); } while (0)
#define ATT_PVM(src, db) do { __builtin_amdgcn_s_setprio(1); _Pragma("unroll") for (int i_ = 0; i_ < 4; ++i_) O[db] = __builtin_amdgcn_mfma_f32_32x32x16_bf16(src[i_], pf[i_], O[db], 0, 0, 0); __builtin_amdgcn_s_setprio(0); } while (0)
#define SCHEDB() __builtin_amdgcn_sched_barrier(0)
    int so_prev = 65536, so_cur = 0, so_next = 32768;
    bf16x8 va[4], vb[4];
    for (int t = 0; t < NT; ++t) {
        LAS unsigned char* cur = lds + so_cur;
        if (t + 1 < NT) ATT_DMA(so_next, t + 1);
        bf16x8 kf[8];
        if (c == 1 && t > 0) { LAS unsigned char* prv = lds + so_prev;
            ATT_VLD(va, prv, 0); SCHEDB(); ATT_VLD(vb, prv, 1); SCHEDB();
            ATT_PVM(va, 0); SCHEDB(); ATT_VLD(va, prv, 2); SCHEDB();
            ATT_PVM(vb, 1); SCHEDB(); ATT_VLD(vb, prv, 3); SCHEDB();
            ATT_PVM(va, 2); SCHEDB();
#pragma unroll
            for (int d0 = 0; d0 < 4; ++d0) { kf[2 * d0] = *(const LAS bf16x8*)(cur + kro + xo[d0]); kf[2 * d0 + 1] = *(const LAS bf16x8*)(cur + kro + 4096 + xo[d0]); }
            SCHEDB(); ATT_PVM(vb, 3); SCHEDB();
        } else {
#pragma unroll
            for (int d0 = 0; d0 < 4; ++d0) { kf[2 * d0] = *(const LAS bf16x8*)(cur + kro + xo[d0]); kf[2 * d0 + 1] = *(const LAS bf16x8*)(cur + kro + 4096 + xo[d0]); }
            SCHEDB();
        }
        f32x16 S0, S1;
        __builtin_amdgcn_s_setprio(1);
        S0 = __builtin_amdgcn_mfma_f32_32x32x16_bf16(kf[0], qr[0], negm, 0, 0, 0);
        S1 = __builtin_amdgcn_mfma_f32_32x32x16_bf16(kf[1], qr[0], negm, 0, 0, 0);
#pragma unroll
        for (int d0 = 1; d0 < 4; ++d0) {
            S0 = __builtin_amdgcn_mfma_f32_32x32x16_bf16(kf[2 * d0], qr[d0], S0, 0, 0, 0);
            S1 = __builtin_amdgcn_mfma_f32_32x32x16_bf16(kf[2 * d0 + 1], qr[d0], S1, 0, 0, 0);
        }
        __builtin_amdgcn_s_setprio(0);
        SCHEDB();
        if (c == 0) { ATT_VLD(va, cur, 0); SCHEDB(); }
        float mx = fmaxf(S0[0], S1[0]);
#pragma unroll
        for (int r = 1; r < 16; ++r) mx = fmaxf(mx, fmaxf(S0[r], S1[r]));
        mx = fmaxf(mx, __shfl_xor(mx, 32));
        if (__any(mx > 8.0f)) {
            const float dl = fmaxf(mx, 0.f), al = __builtin_amdgcn_exp2f(-dl); m += dl; lsum *= al;
#pragma unroll
            for (int r = 0; r < 16; ++r) { S0[r] -= dl; S1[r] -= dl; negm[r] = -m; }
#pragma unroll
            for (int i = 0; i < 4; ++i)
#pragma unroll
                for (int r = 0; r < 16; ++r) O[i][r] *= al;
        }
        float ps = 0.f;
#pragma unroll
        for (int r = 0; r < 16; ++r) { S0[r] = __builtin_amdgcn_exp2f(S0[r]); S1[r] = __builtin_amdgcn_exp2f(S1[r]); ps += S0[r] + S1[r]; }
        lsum += ps;
        { u32x4 w;
          w.x = cvtpk(S0[0], S0[1]); w.y = cvtpk(S0[2], S0[3]); w.z = cvtpk(S0[4], S0[5]); w.w = cvtpk(S0[6], S0[7]); pf[0] = __builtin_bit_cast(bf16x8, w);
          w.x = cvtpk(S0[8], S0[9]); w.y = cvtpk(S0[10], S0[11]); w.z = cvtpk(S0[12], S0[13]); w.w = cvtpk(S0[14], S0[15]); pf[1] = __builtin_bit_cast(bf16x8, w);
          w.x = cvtpk(S1[0], S1[1]); w.y = cvtpk(S1[2], S1[3]); w.z = cvtpk(S1[4], S1[5]); w.w = cvtpk(S1[6], S1[7]); pf[2] = __builtin_bit_cast(bf16x8, w);
          w.x = cvtpk(S1[8], S1[9]); w.y = cvtpk(S1[10], S1[11]); w.z = cvtpk(S1[12], S1[13]); w.w = cvtpk(S1[14], S1[15]); pf[3] = __builtin_bit_cast(bf16x8, w); }
        if (c == 0) { SCHEDB(); ATT_VLD(vb, cur, 1); SCHEDB(); ATT_PVM(va, 0); SCHEDB(); ATT_VLD(va, cur, 2); SCHEDB(); ATT_PVM(vb, 1); SCHEDB(); ATT_VLD(vb, cur, 3); SCHEDB(); ATT_PVM(va, 2); SCHEDB(); ATT_PVM(vb, 3); SCHEDB(); }
        __syncthreads();
        { const int tmp = so_prev; so_prev = so_cur; so_cur = so_next; so_next = tmp; }
    }
    if (c == 1) { LAS unsigned char* prv = lds + so_prev; ATT_VLD(va, prv, 0); ATT_VLD(vb, prv, 1); ATT_PVM(va, 0); ATT_VLD(va, prv, 2); ATT_PVM(vb, 1); ATT_VLD(vb, prv, 3); ATT_PVM(va, 2); ATT_PVM(vb, 3); }
#undef ATT_VLD
#undef ATT_DMA
#undef ATT_PVM
#undef SCHEDB
    __syncthreads();
    lsum += __shfl_xor(lsum, 32);
    const float il = 1.0f / lsum;
    LAS float* xb = (LAS float*)(lds + 65536) + qs * 4096;
    if (c == 1) {
#pragma unroll
        for (int db = 0; db < 4; ++db)
#pragma unroll
            for (int r = 0; r < 16; ++r) xb[(db * 16 + r) * 64 + lane] = O[db][r] * il;
    }
    __syncthreads();
    if (c == 0) {
        float ss = 0.f;
#pragma unroll
        for (int db = 0; db < 4; ++db)
#pragma unroll
            for (int r = 0; r < 16; ++r) { const float o = O[db][r] * il - lam * xb[(db * 16 + r) * 64 + lane]; O[db][r] = o; ss += o * o; }
        ss += __shfl_xor(ss, 32);
        const float rs = onorm / sqrtf(ss * (1.0f / 128.0f) + EPS);
        const int tok = q0 + qs * 32 + r32;
        const bf16_t* zr = za + (size_t)tok * INC; bf16_t* yo = Yo + (size_t)tok * D;
#pragma unroll
        for (int db = 0; db < 4; ++db)
#pragma unroll
            for (int g = 0; g < 4; ++g) { const int d = 32 * db + 8 * g + 4 * hi;
                const f32x4 gs = *(const f32x4*)(gsub + d); const u32x2 z = *(const u32x2*)(zr + d);
                const float o0 = O[db][4 * g] * rs * gs.x * bf2f(z.x & 0xffffu), o1 = O[db][4 * g + 1] * rs * gs.y * bf2f(z.x >> 16);
                const float o2 = O[db][4 * g + 2] * rs * gs.z * bf2f(z.y & 0xffffu), o3 = O[db][4 * g + 3] * rs * gs.w * bf2f(z.y >> 16);
                u32x2 w; w.x = cvtpk(o0, o1); w.y = cvtpk(o2, o3); *(u32x2*)(yo + d) = w; }
    }
    __syncthreads();
}
__device__ __forceinline__ void phase_attn(const Args& a, int l, LAS unsigned char* lds) {
    const int G = gridDim.x;
    const bf16_t* P = (const bf16_t*)(a.ws + WS_P); bf16_t* Y = (bf16_t*)(a.ws + WS_Y);
    const bf16_t* QN = (const bf16_t*)(a.ws + WS_QN); const bf16_t* KC = (const bf16_t*)(a.ws + WS_KC); const bf16_t* VT = (const bf16_t*)(a.ws + WS_VT);
    const float lam = ((const float*)(a.ws + WS_MOD))[4 * 5 * 6144 + l];
    const float lam_init = 0.8f - 0.6f * expf(-0.3f * (float)l);
    const float* gsub = a.in[15] + l * 128;
    for (int L = blockIdx.x; L < 1280; L += G) {
        if (L < 1024) { const int b = L >> 8, h = L & 7, qb = (L >> 3) & 31;
            const size_t qoff = (size_t)PB * 16 * PSEQ * 64 + (size_t)(b * 8 + h) * 2 * SSEQ * 64;
            const size_t koff = (size_t)PB * 16 * PSEQ * 64 + (size_t)(b * 8 + h) * 2 * SNK * 64;
            const size_t voff = (size_t)PB * 8 * 128 * PSEQ + (size_t)(b * 8 + h) * 128 * SNK;
            const size_t tok0 = (size_t)NPROMPT + (size_t)b * SSEQ;
            attn_item(lds, QN + qoff, SSEQ, KC + koff, VT + voff, SNK, qb * 128, lam, 1.0f - lam_init, gsub + 0, P + tok0 * INC + C_ZA + h * 128, Y + tok0 * D + 1024 + h * 128);
        } else { const int M_ = L - 1024, b = M_ >> 4, h = (M_ >> 1) & 7, qb = M_ & 1;
            const size_t qoff = (size_t)(b * 8 + h) * 2 * PSEQ * 64, voff = (size_t)(b * 8 + h) * 128 * PSEQ;
            const size_t tok0 = (size_t)b * PSEQ;
            attn_item(lds, QN + qoff, PSEQ, KC + qoff, VT + voff, PSEQ, qb * 128, lam, 1.0f - lam_init, gsub + 0, P + tok0 * INC + C_ZA + h * 128, Y + tok0 * D + 1024 + h * 128);
        }
    }
}

#define XB_TMO      128
#define XB_XCNT(j)  (256  + 64 * (j))
#define XB_XSUB(j)  (1280 + 64 * (j))
#define XB_XGEN(j)  (2304 + 64 * (j))
#define XB_TOP      3328
#define XB_TOPGEN   3392
#define XCD_BAR_WORDS 3456
#define XB_SPIN_CAP (1u << 20)
__device__ __forceinline__ unsigned xb_ld(unsigned* p)              { return __hip_atomic_load(p, __ATOMIC_RELAXED, __HIP_MEMORY_SCOPE_AGENT); }
__device__ __forceinline__ unsigned xb_add(unsigned* p, unsigned v) { return __hip_atomic_fetch_add(p, v, __ATOMIC_RELAXED, __HIP_MEMORY_SCOPE_AGENT); }
__device__ __forceinline__ unsigned xb_xcc_id() { return (unsigned)__builtin_amdgcn_s_getreg((3 << 11) | 20) & 0xFu; }
#define XB_SPIN(cond, bar) do { unsigned _sp = 0; while (cond) { __builtin_amdgcn_s_sleep(1); \
    if ((++_sp & 255u) == 0u) { if (xb_ld(&(bar)[XB_TMO])) break; if (_sp > XB_SPIN_CAP) { atomicAdd(&(bar)[XB_TMO], 1u); break; } } } } while (0)
struct XcdBarrier { unsigned* bar; unsigned x; volatile LAS unsigned* st; };
__device__ __forceinline__ XcdBarrier xcd_barrier_post(unsigned* bar, volatile LAS unsigned* st) {
    XcdBarrier b; b.bar = bar; b.x = xb_xcc_id(); b.st = st;
    if (threadIdx.x == 0) (void)xb_add(&bar[XB_XCNT(b.x)], 1u);
    return b;
}
__device__ __forceinline__ void xcd_barrier_complete(unsigned* bar, unsigned x, unsigned& nloc, unsigned& nx) {
    const unsigned G = gridDim.x * gridDim.y * gridDim.z;
    unsigned sum, cnt, mine, sp = 0u;
    for (;;) {
        sum = 0u; cnt = 0u; mine = 0u;
#pragma unroll
        for (unsigned j = 0; j < 16; ++j) { const unsigned c = xb_ld(&bar[XB_XCNT(j)]); sum += c; cnt += (c > 0u) ? 1u : 0u; mine = (j == x) ? c : mine; }
        if (sum == G) break;
        __builtin_amdgcn_s_sleep(1);
        if ((++sp & 255u) == 0u) { if (xb_ld(&bar[XB_TMO])) break; if (sp > XB_SPIN_CAP) { atomicAdd(&bar[XB_TMO], 1u); break; } }
    }
    nloc = mine > 0u ? mine : 1u; nx = cnt > 0u ? cnt : 1u;
}
__device__ __forceinline__ void xcd_barrier(const XcdBarrier& b) {
    asm volatile("s_waitcnt vmcnt(0)" ::: "memory");
    __syncthreads();
    if (threadIdx.x == 0) {
        unsigned* bar = b.bar;
        __builtin_amdgcn_s_waitcnt(0);
        unsigned nloc = b.st[0], nx = b.st[1];
        if (nloc == 0u) { xcd_barrier_complete(bar, b.x, nloc, nx); b.st[0] = nloc; b.st[1] = nx; }
        const unsigned old = xb_add(&bar[XB_XSUB(b.x)], 1u);
        const unsigned gen = old / nloc;
        if (old + 1u == (gen + 1u) * nloc) {
            __builtin_amdgcn_fence(__ATOMIC_RELEASE, "agent");
            asm volatile("s_waitcnt vmcnt(0)" ::: "memory");
            const unsigned og = xb_add(&bar[XB_TOP], 1u);
            const unsigned tg = og / nx;
            if (og + 1u == (tg + 1u) * nx) xb_add(&bar[XB_TOPGEN], 1u);
            else XB_SPIN(xb_ld(&bar[XB_TOPGEN]) == tg, bar);
            __builtin_amdgcn_fence(__ATOMIC_ACQUIRE, "agent");
            xb_add(&bar[XB_XGEN(b.x)], 1u);
            asm volatile("s_waitcnt vmcnt(0)" ::: "memory");
        } else {
            XB_SPIN(xb_ld(&bar[XB_XGEN(b.x)]) == gen, bar);
            __builtin_amdgcn_fence(__ATOMIC_ACQUIRE, "agent");
            asm volatile("s_waitcnt vmcnt(0)" ::: "memory");
        }
    }
    __syncthreads();
}

#ifndef PHMASK
#define PHMASK 0xFFFF
#endif
#define REP_IN 1
#define REP_ATTN 1
#define REP_POS 1
#define REP_PREP 1
#define REP_MERGE 1
#define REP_PRE0 1
#define REP_NORM 1
#define REP_CHAN 1
__global__ void __launch_bounds__(512, 2) fwd_kernel(Args a) {
    extern __shared__ __attribute__((aligned(16))) unsigned char lds_raw[];
    LAS unsigned char* lds = (LAS unsigned char*)lds_raw;
    cg::grid_group grid = cg::this_grid();
    const int G = gridDim.x, c = blockIdx.x;
    unsigned char* ws = a.ws;
    int ph = 0;
    volatile LAS unsigned* bst = (volatile LAS unsigned*)(lds + 131072 + 512);
    if (threadIdx.x < 2) bst[threadIdx.x] = 0u;
    __syncthreads();
    const XcdBarrier xbar = xcd_barrier_post((unsigned*)(ws + WS_CTL), bst);
#define SEAM() do { if (a.ph_lo <= ph && ph + 1 < a.ph_hi) { if (ph == 0) grid.sync(); else xcd_barrier(xbar); } ++ph; } while (0)
#define IN_PH() (a.ph_lo <= ph && ph < a.ph_hi)
    if (IN_PH()) { if constexpr (PHMASK & 1) for (int rep = 0; rep < REP_PRE0; ++rep) { phase_pre0(a, lds); __syncthreads(); } }
    SEAM();
    if (IN_PH()) { if constexpr (PHMASK & 2) phase_pre1(a); }
    SEAM();
#pragma unroll 1
    for (int l = 0; l < DEPTH; ++l) {
        if (IN_PH()) { if constexpr (PHMASK & 4) for (int rep = 0; rep < REP_NORM; ++rep) phase_norm(a, l); }
        SEAM();
        const char* Hb = (const char*)(ws + WS_H); const char* WIl = (const char*)(ws + WS_WIN) + (size_t)l * INC * D * 2; const size_t trs_ = (size_t)256 * D * 2;
        const EpiIn EI{(bf16_t*)(ws + WS_P), (bf16_t*)(ws + WS_QN), (bf16_t*)(ws + WS_KC), a.out + (size_t)41943040, a.in[13] + l * 64, a.in[14] + l * 64, (const float*)(ws + WS_TAB + 512 * 1024), l, ws + WS_GN, ws + WS_ZN};
        const pg8::Gemm gI{D, D, D};
        if (IN_PH()) if constexpr (PHMASK & 8) {
            { pg8::Order<pg8::MapGrid> S{80 * 32, G, c, pg8::MapGrid{Hb, WIl, 80, 32, trs_, trs_, 0, 0}};
              for (int rep = 0; rep < REP_IN; ++rep) pg8::gemm_phase(lds, gI, S, EI); }
            { pg8::Order<pg8::MapGrid> S{64 * 8, G, c, pg8::MapGrid{Hb, WIl, 64, 8, trs_, trs_, 0, 32}};
              pg8::gemm_phase(lds, gI, S, EI); }
        }
        SEAM();
        if (IN_PH()) if constexpr (PHMASK & 16) {
            if (c < (G >> 1)) { pg8::Order<pg8::MapGrid> S{16 * 8, G >> 1, c, pg8::MapGrid{Hb, WIl, 16, 8, trs_, trs_, 64, 32}}; pg8::gemm_phase(lds, gI, S, EI); }
            else { pg8::Gemm g{256, INC, 256};
                pg8::Order<MapChan> S{640, G - (G >> 1), c - (G >> 1), MapChan{(const char*)(ws + WS_TAB + 256 * 1024), (const char*)(ws + WS_P)}};
                EpiStore E{(bf16_t*)(ws + WS_ABT)};
                for (int rep = 0; rep < REP_CHAN; ++rep) pg8::gemm_phase(lds, g, S, E); }
        }
        SEAM();
        if (IN_PH()) {
            if constexpr (PHMASK & 32) for (int rep = 0; rep < REP_PREP; ++rep) phase_prep(a, l, lds);
            phase_fold(a);
        }
        SEAM();
        if (IN_PH()) if constexpr (PHMASK & 64) {
            { pg8::Gemm g{4096, 4096, 4096};
              pg8::Order<MapPosS> S{256, G, c, MapPosS{(const char*)(ws + WS_T4096), (const char*)(ws + WS_T4096 + 32 * MiB)}};
              EpiPos E{ws + WS_ZN, (bf16_t*)(ws + WS_Y)};
              for (int rep = 0; rep < REP_POS; ++rep) pg8::gemm_phase(lds, g, S, E); }
            { pg8::Gemm g{512, 512, 512};
              pg8::Order<MapPosP> S{64, G, c, MapPosP{(const char*)(ws + WS_TAB), (const char*)(ws + WS_ABT)}};
              EpiPos E{ws + WS_ZN, (bf16_t*)(ws + WS_Y)};
              pg8::gemm_phase(lds, g, S, E); }
            if constexpr (PHMASK & 128) for (int rep = 0; rep < REP_ATTN; ++rep) phase_attn(a, l, lds);
        }
        SEAM();
        const char* Yb = (const char*)(ws + WS_Y); const char* MGb = (const char*)(ws + WS_H);
        const char* WMl = (const char*)(ws + WS_WM) + (size_t)l * D * D * 2; const char* WOl = (const char*)(ws + WS_WO) + (size_t)l * D * D * 2;
        const size_t trs = (size_t)256 * D * 2;
        const EpiMerge EM{ws + WS_GN, (bf16_t*)(ws + WS_H)};
        const EpiOut EO{(l == 0) ? a.in[0] : a.out, (l == 0) ? a.in[1] : a.out + (size_t)NPROMPT * D, a.out, (const float*)(ws + WS_MOD) + (size_t)l * 5 * 6144};
        const pg8::Gemm gD{D, D, D};
        if (IN_PH()) if constexpr (PHMASK & 256) {
            pg8::Order<pg8::MapGrid> S{64 * 8, G, c, pg8::MapGrid{Yb, WMl, 64, 8, trs, trs, 0, 0}};
            for (int rep = 0; rep < REP_MERGE; ++rep) pg8::gemm_phase(lds, gD, S, EM);
        }
        SEAM();
        if (IN_PH()) if constexpr (PHMASK & 512) {
            if (c < (G >> 1)) { pg8::Order<pg8::MapGrid> S{16 * 8, G >> 1, c, pg8::MapGrid{Yb, WMl, 16, 8, trs, trs, 64, 0}}; pg8::gemm_phase(lds, gD, S, EM); }
            else { pg8::Order<pg8::MapGrid> S{16 * 8, G - (G >> 1), c - (G >> 1), pg8::MapGrid{MGb, WOl, 16, 8, trs, trs, 0, 0}}; pg8::gemm_phase(lds, gD, S, EO); }
        }
        SEAM();
        if (IN_PH()) if constexpr (PHMASK & 512) {
            pg8::Order<pg8::MapGrid> S{64 * 8, G, c, pg8::MapGrid{MGb, WOl, 64, 8, trs, trs, 16, 0}};
            pg8::gemm_phase(lds, gD, S, EO);
        }
        SEAM();
    }
#undef SEAM
#undef IN_PH
}
constexpr int N_PHASES = 2 + 8 * DEPTH;

extern "C" void kernel_launch(void* const* d_in, const int* in_sizes, int n_in, void* d_out, int out_size, void* d_ws, size_t ws_size, hipStream_t stream) {
    static int grid = 0;
    if (grid == 0) {
        if (n_in != 20 || ws_size < WS_END) { fprintf(stderr, "kernel_launch: unexpected n_in %d or ws_size %zu (< %zu)\n", n_in, ws_size, (size_t)WS_END); grid = -1; return; }
        int dev = 0, cus = 0, per_cu = 0;
        hipGetDevice(&dev); hipDeviceGetAttribute(&cus, hipDeviceAttributeMultiprocessorCount, dev);
        if (hipFuncSetAttribute((const void*)fwd_kernel, hipFuncAttributeMaxDynamicSharedMemorySize, LDS_BYTES) != hipSuccess) { fprintf(stderr, "kernel_launch: hipFuncSetAttribute failed\n"); grid = -1; return; }
        hipOccupancyMaxActiveBlocksPerMultiprocessor(&per_cu, (const void*)fwd_kernel, 512, LDS_BYTES);
        (void)hipGetLastError();
        if (per_cu < 1) { fprintf(stderr, "kernel_launch: occupancy query says %d blocks per CU\n", per_cu); per_cu = 1; }
        grid = cus * 1;
    }
    if (grid < 0) return;
    if (hipMemsetAsync((char*)d_ws + WS_CTL, 0, XCD_BAR_WORDS * 4, stream) != hipSuccess) { fprintf(stderr, "kernel_launch: hipMemsetAsync failed\n"); return; }
    Args a{};
    for (int i = 0; i < 20; ++i) a.in[i] = (const float*)d_in[i];
    a.out = (float*)d_out; a.ws = (unsigned char*)d_ws; a.ph_lo = 0; a.ph_hi = N_PHASES;
    void* params[] = {&a};
    hipError_t e = hipLaunchCooperativeKernel((const void*)fwd_kernel, dim3(grid), dim3(512), params, LDS_BYTES, stream);
    if (e != hipSuccess) fprintf(stderr, "cooperative launch failed: %s (grid %d)\n", hipGetErrorString(e), grid);
}
```
